# Optimizing an MI355X kernel written in HIP

```python
import jax, jax.numpy as jnp
from jax import lax
import numpy as np

D_MODEL = 1024
BATCH = 8
SEQ = 8192
DEPTH = 4

CTX_LEN = 256
GRID_W = 64
D_MIX = D_MODEL
D_RNN = D_MIX // 2
D_ATTN = D_MIX - D_RNN
HEAD_DIM = 64
N_Q_HEADS = D_ATTN // HEAD_DIM
N_KV_HEADS = 2
GQ = N_Q_HEADS // N_KV_HEADS
D_KV = N_KV_HEADS * HEAD_DIM
WINDOW = 128
BLK = 128
ATTN_SCALE = HEAD_DIM ** -0.5
AXIS_DIM = HEAD_DIM // 2
ROPE_BASE = 10000.0
RG_BLOCKS = 8
RG_BD = D_RNN // RG_BLOCKS
RG_C = 8.0
CONV_W = 4
CONV_LEFT = 2
N_GROUPS = 4
EXP_PER_GROUP = 8
N_EXPERTS = N_GROUPS * EXP_PER_GROUP
TOP_K = 2
D_EXPERT = 512
MOE_BLK = 128
D_IN = 2 * D_RNN + D_ATTN + 2 * D_KV
ALPHA = (2 * DEPTH) ** 0.25
BETA = (8 * DEPTH) ** -0.25
LN_EPS = 1e-6
NEG_INF = -1e30

kernel_name = "hybrid_rglru_swa_hmoe_diffusion_trunk"


def layer_norm(x, g, b):
    xf = x.astype(jnp.float32)
    mu = jnp.mean(xf, -1, keepdims=True)
    var = jnp.mean(jnp.square(xf - mu), -1, keepdims=True)
    return ((xf - mu) * lax.rsqrt(var + LN_EPS) * g + b).astype(x.dtype)


def modulate(x, shift, scale):
    xf = x.astype(jnp.float32)
    mu = jnp.mean(xf, -1, keepdims=True)
    var = jnp.mean(jnp.square(xf - mu), -1, keepdims=True)
    return ((xf - mu) * lax.rsqrt(var + LN_EPS)).astype(x.dtype) * (1.0 + scale) + shift


def rms_norm(x, g):
    xf = x.astype(jnp.float32)
    return (xf * lax.rsqrt(jnp.mean(jnp.square(xf), -1, keepdims=True) + LN_EPS) * g).astype(x.dtype)


def axial_rope_tables(seq):
    rows = seq // GRID_W
    row = jnp.repeat(jnp.arange(rows, dtype=jnp.float32), GRID_W)
    col = jnp.tile(jnp.arange(GRID_W, dtype=jnp.float32), rows)
    inv = ROPE_BASE ** (-jnp.arange(0, AXIS_DIM, 2, dtype=jnp.float32) / AXIS_DIM)
    ang_r = row[:, None] * inv
    ang_c = col[:, None] * inv
    return (jnp.cos(ang_r), jnp.sin(ang_r), jnp.cos(ang_c), jnp.sin(ang_c))


def _rotate(x, cos, sin):
    cos = cos[None, :, None, :].astype(x.dtype)
    sin = sin[None, :, None, :].astype(x.dtype)
    x1, x2 = jnp.split(x, 2, axis=-1)
    return jnp.concatenate([x1 * cos - x2 * sin, x2 * cos + x1 * sin], -1)


def rope_axial(x, rope):
    cos_r, sin_r, cos_c, sin_c = rope
    return jnp.concatenate([_rotate(x[..., :AXIS_DIM], cos_r, sin_r),
                            _rotate(x[..., AXIS_DIM:], cos_c, sin_c)], -1)


def centred_dwconv(u, w, b):
    L = u.shape[1]
    up = jnp.pad(u, ((0, 0), (CONV_LEFT, CONV_W - 1 - CONV_LEFT), (0, 0)))
    out = b
    for j in range(CONV_W):
        out = out + up[:, j:j + L] * w[j]
    return out


def _linear_recurrence_combine(e1, e2):
    a1, b1 = e1
    a2, b2 = e2
    return a1 * a2, a2 * b1 + b2


def rglru_scan(x, wa, ba, wx, bx, lam, h0, reverse):
    B, L, C = x.shape
    xh = x.reshape(B, L, RG_BLOCKS, RG_BD)
    r = jax.nn.sigmoid(jnp.einsum('blhi,hij->blhj', xh, wa).reshape(B, L, C) + ba)
    gi = jax.nn.sigmoid(jnp.einsum('blhi,hij->blhj', xh, wx).reshape(B, L, C) + bx)
    log_a = -RG_C * r.astype(jnp.float32) * jax.nn.softplus(-lam.astype(jnp.float32))
    a = jnp.exp(log_a)
    b = jnp.sqrt(-jnp.expm1(2.0 * log_a)) * (gi * x).astype(jnp.float32)
    if reverse:
        a = jnp.flip(a, 1)
        b = jnp.flip(b, 1)
    b = b.at[:, 0].add(a[:, 0] * h0)
    _, h = lax.associative_scan(_linear_recurrence_combine, (a, b), axis=1)
    h_end = h[:, -1]
    if reverse:
        h = jnp.flip(h, 1)
    return h.astype(x.dtype), h_end


def rglru_group(u_lat, u_ctx, conv_w, conv_b, wa, ba, wx, bx, lam, with_ctx_out):
    x_lat = centred_dwconv(u_lat, conv_w, conv_b)
    x_ctx = centred_dwconv(u_ctx, conv_w, conv_b)
    h0 = jnp.zeros((u_ctx.shape[0], D_RNN), jnp.float32)
    y_lat = 0.0
    y_ctx = 0.0
    for d in range(2):
        rev = d == 1
        h_ctx, h_end = rglru_scan(x_ctx, wa[d], ba[d], wx[d], bx[d], lam[d], h0, rev)
        h_lat, _ = rglru_scan(x_lat, wa[d], ba[d], wx[d], bx[d], lam[d], h_end, rev)
        y_lat = y_lat + h_lat
        if with_ctx_out:
            y_ctx = y_ctx + h_ctx
    return y_lat, (y_ctx if with_ctx_out else None)


def window_attention(q, k, v, kc, vc, sink):
    B, S = q.shape[:2]
    nb = S // BLK
    qb = q.reshape(B, nb, BLK, N_KV_HEADS, GQ, HEAD_DIM)
    pad = ((0, 0), (BLK, BLK), (0, 0), (0, 0))
    kp = jnp.pad(k, pad).reshape(B, nb + 2, BLK, N_KV_HEADS, HEAD_DIM)
    vp = jnp.pad(v, pad).reshape(B, nb + 2, BLK, N_KV_HEADS, HEAD_DIM)
    kb = jnp.concatenate([kp[:, :-2], kp[:, 1:-1], kp[:, 2:]], axis=2)
    vb = jnp.concatenate([vp[:, :-2], vp[:, 1:-1], vp[:, 2:]], axis=2)
    s_band = jnp.einsum('bnqhgd,bnkhd->bnhgqk', qb, kb).astype(jnp.float32) * ATTN_SCALE
    offs = jnp.arange(3 * BLK) - BLK
    in_win = jnp.abs(offs[None, :] - jnp.arange(BLK)[:, None]) <= WINDOW
    kpos = jnp.arange(nb)[:, None] * BLK + offs[None, :]
    in_rng = (kpos >= 0) & (kpos < S)
    mask = in_win[None] & in_rng[:, None, :]
    s_band = jnp.where(mask[None, :, None, None], s_band, NEG_INF)
    s_ctx = jnp.einsum('bnqhgd,bchd->bnhgqc', qb, kc).astype(jnp.float32) * ATTN_SCALE
    s_sink = jnp.broadcast_to(sink.astype(jnp.float32).reshape(1, 1, N_KV_HEADS, GQ, 1, 1),
                              s_band.shape[:-1] + (1,))
    p = jax.nn.softmax(jnp.concatenate([s_band, s_ctx, s_sink], -1), axis=-1)
    C = kc.shape[1]
    p_band = p[..., :3 * BLK].astype(v.dtype)
    p_ctx = p[..., 3 * BLK:3 * BLK + C].astype(v.dtype)
    o = (jnp.einsum('bnhgqk,bnkhd->bnqhgd', p_band, vb)
         + jnp.einsum('bnhgqc,bchd->bnqhgd', p_ctx, vc))
    return o.reshape(B, S, D_ATTN)


def context_attention(qc, kc, vc, sink):
    B, C = qc.shape[:2]
    qg = qc.reshape(B, C, N_KV_HEADS, GQ, HEAD_DIM)
    s = jnp.einsum('bqhgd,bkhd->bhgqk', qg, kc).astype(jnp.float32) * ATTN_SCALE
    s_sink = jnp.broadcast_to(sink.astype(jnp.float32).reshape(1, N_KV_HEADS, GQ, 1, 1),
                              s.shape[:-1] + (1,))
    p = jax.nn.softmax(jnp.concatenate([s, s_sink], -1), axis=-1)[..., :C]
    o = jnp.einsum('bhgqk,bkhd->bqhgd', p.astype(vc.dtype), vc)
    return o.reshape(B, C, D_ATTN)


def token_mixer(h_lat, h_ctx, rope, w_in, conv_w, conv_b, rg_wa, rg_ba, rg_wx, rg_bx, rg_lam,
                sink, gn_rnn, gn_attn, w_out, with_ctx_out):
    B, S, _ = h_lat.shape
    C = h_ctx.shape[1]
    cuts = [D_RNN, 2 * D_RNN, 2 * D_RNN + D_ATTN, 2 * D_RNN + D_ATTN + D_KV]
    u_l, g_l, q_l, k_l, v_l = jnp.split(h_lat @ w_in, cuts, axis=-1)
    u_c, g_c, q_c, k_c, v_c = jnp.split(h_ctx @ w_in, cuts, axis=-1)
    r_l, r_c = rglru_group(u_l, u_c, conv_w, conv_b, rg_wa, rg_ba, rg_wx, rg_bx, rg_lam, with_ctx_out)
    q_l = rope_axial(q_l.reshape(B, S, N_Q_HEADS, HEAD_DIM), rope)
    k_l = rope_axial(k_l.reshape(B, S, N_KV_HEADS, HEAD_DIM), rope)
    v_l = v_l.reshape(B, S, N_KV_HEADS, HEAD_DIM)
    k_c = k_c.reshape(B, C, N_KV_HEADS, HEAD_DIM)
    v_c = v_c.reshape(B, C, N_KV_HEADS, HEAD_DIM)
    a_l = window_attention(q_l, k_l, v_l, k_c, v_c, sink)
    o_lat = jnp.concatenate([rms_norm(r_l * jax.nn.gelu(g_l), gn_rnn),
                             rms_norm(a_l, gn_attn)], -1) @ w_out
    if not with_ctx_out:
        return o_lat, None
    a_c = context_attention(q_c, k_c, v_c, sink)
    o_ctx = jnp.concatenate([rms_norm(r_c * jax.nn.gelu(g_c), gn_rnn),
                             rms_norm(a_c, gn_attn)], -1) @ w_out
    return o_lat, o_ctx


def hier_moe(xf, wg, bg, we, be, w1, w3, w2):
    T, D = xf.shape
    g_logits = (xf @ wg + bg).astype(jnp.float32)
    g_prob = jax.nn.softmax(g_logits, -1)
    _, g_sel = lax.top_k(g_logits, 1)
    p_g = jnp.take_along_axis(g_prob, g_sel, axis=-1)
    e_logits = (xf @ we + be).astype(jnp.float32).reshape(T, N_GROUPS, EXP_PER_GROUP)
    e_in = jnp.take_along_axis(e_logits, g_sel[:, :, None], axis=1)[:, 0]
    top_v, top_i = lax.top_k(e_in, TOP_K)
    gate = (jax.nn.softmax(top_v, -1) * p_g).astype(xf.dtype)
    expert_id = (g_sel * EXP_PER_GROUP + top_i).astype(jnp.int32)
    TK = T * TOP_K
    n_blocks = (TK + N_EXPERTS * (MOE_BLK - 1) + MOE_BLK - 1) // MOE_BLK
    flat_e = expert_id.reshape(-1)
    order = jnp.argsort(flat_e)
    sorted_e = flat_e[order]
    counts = jax.ops.segment_sum(jnp.ones_like(flat_e), flat_e, num_segments=N_EXPERTS)
    starts = jnp.cumsum(counts) - counts
    pcounts = (counts + MOE_BLK - 1) // MOE_BLK * MOE_BLK
    pends = jnp.cumsum(pcounts)
    pstarts = pends - pcounts
    dest = pstarts[sorted_e] + (jnp.arange(TK, dtype=jnp.int32) - starts[sorted_e])
    tok_sorted = (order // TOP_K).astype(jnp.int32)
    slot_tok = jnp.full((n_blocks * MOE_BLK,), T, jnp.int32).at[dest].set(tok_sorted)
    x_pad = jnp.concatenate([xf, jnp.zeros((1, D), xf.dtype)], 0)
    xb = x_pad[slot_tok].reshape(n_blocks, MOE_BLK, D)
    blk_e = jnp.minimum(jnp.searchsorted(pends, jnp.arange(n_blocks) * MOE_BLK, side='right'),
                        N_EXPERTS - 1)

    def run_block(args):
        xblk, e = args
        h = jax.nn.silu(xblk @ w1[e]) * (xblk @ w3[e])
        return h @ w2[e]

    yb = lax.map(run_block, (xb, blk_e)).reshape(n_blocks * MOE_BLK, D)
    y_assign = yb[dest] * gate.reshape(-1)[order][:, None]
    return jax.ops.segment_sum(y_assign, tok_sorted, num_segments=T)


def setup_inputs(seed: int = 0) -> dict:
    key = jax.random.key(seed)
    ks = jax.random.split(key, 32)
    L = DEPTH

    def nrm(k, shape, s):
        return jax.random.normal(k, shape, jnp.float32) * s

    u = jax.random.uniform(ks[10], (L, 2, D_RNN), jnp.float32, minval=0.9, maxval=0.999)
    a0 = u ** (1.0 / RG_C)
    rg_lam = jnp.log(a0) - jnp.log1p(-a0)
    return {
        "x": nrm(ks[0], (BATCH, SEQ, D_MODEL), 1.0),
        "c": nrm(ks[1], (BATCH, D_MODEL), 1.0),
        "ctx": nrm(ks[2], (BATCH, CTX_LEN, D_MODEL), 1.0),
        "c_ctx": nrm(ks[3], (D_MODEL,), 1.0),
        "w_mod": nrm(ks[4], (L, D_MODEL, 6 * D_MODEL), 0.5 * D_MODEL ** -0.5),
        "b_mod": nrm(ks[5], (L, 6 * D_MODEL), 0.01),
        "w_in": nrm(ks[6], (L, D_MODEL, D_IN), D_MODEL ** -0.5),
        "conv_w": nrm(ks[7], (L, CONV_W, D_RNN), CONV_W ** -0.5),
        "conv_b": nrm(ks[8], (L, D_RNN), 0.01),
        "rg_wa": nrm(ks[9], (L, 2, RG_BLOCKS, RG_BD, RG_BD), RG_BD ** -0.5),
        "rg_ba": nrm(ks[11], (L, 2, D_RNN), 0.01),
        "rg_wx": nrm(ks[12], (L, 2, RG_BLOCKS, RG_BD, RG_BD), RG_BD ** -0.5),
        "rg_bx": nrm(ks[13], (L, 2, D_RNN), 0.01),
        "rg_lam": rg_lam,
        "attn_sink": nrm(ks[14], (L, N_Q_HEADS), 0.5),
        "gn_rnn": 1.0 + nrm(ks[15], (L, D_RNN), 0.02),
        "gn_attn": 1.0 + nrm(ks[16], (L, D_ATTN), 0.02),
        "w_out": nrm(ks[17], (L, D_MIX, D_MODEL), BETA * D_MIX ** -0.5),
        "ln1_g": 1.0 + nrm(ks[18], (L, D_MODEL), 0.02),
        "ln1_b": nrm(ks[19], (L, D_MODEL), 0.01),
        "router_g": nrm(ks[20], (L, D_MODEL, N_GROUPS), D_MODEL ** -0.5),
        "router_gb": nrm(ks[21], (L, N_GROUPS), 0.01),
        "router_e": nrm(ks[22], (L, D_MODEL, N_EXPERTS), D_MODEL ** -0.5),
        "router_eb": nrm(ks[23], (L, N_EXPERTS), 0.01),
        "w1": nrm(ks[24], (L, N_EXPERTS, D_MODEL, D_EXPERT), D_MODEL ** -0.5),
        "w3": nrm(ks[25], (L, N_EXPERTS, D_MODEL, D_EXPERT), D_MODEL ** -0.5),
        "w2": nrm(ks[26], (L, N_EXPERTS, D_EXPERT, D_MODEL), BETA * D_EXPERT ** -0.5),
        "ln2_g": 1.0 + nrm(ks[27], (L, D_MODEL), 0.02),
        "ln2_b": nrm(ks[28], (L, D_MODEL), 0.01),
    }


def reference(x, c, ctx, c_ctx, w_mod, b_mod, w_in, conv_w, conv_b, rg_wa, rg_ba, rg_wx, rg_bx,
              rg_lam, attn_sink, gn_rnn, gn_attn, w_out, ln1_g, ln1_b, router_g, router_gb,
              router_e, router_eb, w1, w3, w2, ln2_g, ln2_b):
    B, S, D = x.shape
    rope = axial_rope_tables(S)
    silu_c = jax.nn.silu(c)
    silu_cc = jax.nn.silu(c_ctx)
    xc = ctx
    for l in range(DEPTH):
        last = l == DEPTH - 1
        m_lat = silu_c @ w_mod[l] + b_mod[l]
        m_ctx = silu_cc @ w_mod[l] + b_mod[l]
        sh1, sc1, g1, sh2, sc2, g2 = jnp.split(m_lat[:, None, :], 6, axis=-1)
        sh1c, sc1c, g1c, sh2c, sc2c, g2c = jnp.split(m_ctx, 6)
        h_lat = modulate(x, sh1, sc1)
        h_ctx = modulate(xc, sh1c, sc1c)
        y_lat, y_ctx = token_mixer(h_lat, h_ctx, rope, w_in[l], conv_w[l], conv_b[l], rg_wa[l],
                                   rg_ba[l], rg_wx[l], rg_bx[l], rg_lam[l], attn_sink[l],
                                   gn_rnn[l], gn_attn[l], w_out[l], not last)
        x = layer_norm(ALPHA * x + g1 * y_lat, ln1_g[l], ln1_b[l])
        h_lat = modulate(x, sh2, sc2).reshape(B * S, D)
        if last:
            y = hier_moe(h_lat, router_g[l], router_gb[l], router_e[l], router_eb[l],
                         w1[l], w3[l], w2[l])
            x = layer_norm(ALPHA * x + g2 * y.reshape(B, S, D), ln2_g[l], ln2_b[l])
        else:
            xc = layer_norm(ALPHA * xc + g1c * y_ctx, ln1_g[l], ln1_b[l])
            h_ctx = modulate(xc, sh2c, sc2c).reshape(-1, D)
            y = hier_moe(jnp.concatenate([h_lat, h_ctx], 0), router_g[l], router_gb[l],
                         router_e[l], router_eb[l], w1[l], w3[l], w2[l])
            x = layer_norm(ALPHA * x + g2 * y[:B * S].reshape(B, S, D), ln2_g[l], ln2_b[l])
            xc = layer_norm(ALPHA * xc + g2c * y[B * S:].reshape(xc.shape), ln2_g[l], ln2_b[l])
    return x
```

```cpp
#include <hip/hip_runtime.h>
#include <cstdio>
#include <cstdint>

#define DI __device__ __forceinline__
#define LAS __attribute__((address_space(3)))
#define GAS __attribute__((address_space(1)))

typedef unsigned short bf16_t;
typedef short bf16x8 __attribute__((ext_vector_type(8)));
typedef short s16x4 __attribute__((ext_vector_type(4)));
typedef float f32x4 __attribute__((ext_vector_type(4)));
typedef float f32x2 __attribute__((ext_vector_type(2)));
typedef float f32x16 __attribute__((ext_vector_type(16)));
typedef unsigned u32x4 __attribute__((ext_vector_type(4)));
typedef unsigned u32x2 __attribute__((ext_vector_type(2)));

constexpr int D = 1024, NB = 8, SEQ = 8192, DEPTH = 4, CL = 256;
constexpr int NLAT = NB * SEQ, NCTX = NB * CL, NT = NLAT + NCTX;
constexpr int DIN = 1792, DR = 512;
constexpr int NE = 32, DE = 512;
constexpr int MPAD = 143360;
constexpr float ALPHA = 1.6817928305074292f;
constexpr float LN_EPS = 1e-6f;
constexpr float LOG2E = 1.4426950408889634f;

constexpr size_t MiB = 1u << 20;
constexpr size_t WS_CTL = 0, CTL_ZERO_BYTES = 1 * MiB;
constexpr size_t WS_MOD = 1 * MiB;
constexpr size_t WS_ROPE = 2 * MiB;
constexpr size_t WS_SNT = 2 * MiB + 131072;
constexpr size_t WS_ROWST = 2 * MiB + 262144;
constexpr size_t WS_TILEE = 2 * MiB + 65536;
constexpr size_t WS_WIN = 3 * MiB;
constexpr size_t WS_WOUT = 17 * MiB;
constexpr size_t WS_WR = 25 * MiB;
constexpr size_t WS_W13 = 27 * MiB;
constexpr size_t WS_XB = 155 * MiB;
constexpr size_t WS_W2 = 283 * MiB;
constexpr size_t WS_WRB = 347 * MiB;
constexpr size_t WS_DUMMY = 352 * MiB;
constexpr size_t WS_XC = 411 * MiB;
constexpr size_t WS_HA = 419 * MiB;
constexpr size_t WS_LOG = 551 * MiB;
constexpr size_t WS_TOKE = 568 * MiB;
constexpr size_t WS_TOKG = 569 * MiB;
constexpr size_t WS_TOKR = 570 * MiB;
constexpr size_t WS_SLOTTOK = 571 * MiB;
constexpr size_t WS_R = 572 * MiB;
constexpr size_t WS_U = WS_R, WS_G = WS_R + 66 * MiB, WS_Q = WS_R + 132 * MiB, WS_KB = WS_R + 198 * MiB, WS_VT = WS_R + 215 * MiB;
constexpr size_t WS_VTC = WS_VT + 16 * MiB;
constexpr size_t WS_HF = WS_R + 232 * MiB, WS_HB = WS_R + 298 * MiB, WS_Y = WS_R + 364 * MiB;
constexpr size_t WS_XCV = WS_R + 364 * MiB;
constexpr size_t WS_HMOE = WS_R, WS_YMOE = WS_R + 232 * MiB;
constexpr size_t WS_HA8 = WS_R + 232 * MiB;
constexpr size_t WS_END = WS_R + 496 * MiB;
static_assert(WS_KB + (size_t)NT * 128 * 2 <= WS_VT && WS_VTC + (size_t)NB * 2 * 64 * CL * 2 <= WS_HF && WS_Y + (size_t)NT * D * 2 <= WS_END, "ws map");
static_assert(WS_W13 + (size_t)DEPTH * NE * 1024 * 1024 <= WS_XB && WS_XB + (size_t)NLAT * D * 2 <= WS_W2, "ws map xb");
static_assert(WS_HMOE + (size_t)MPAD * DE <= WS_HA8 && WS_VTC + (size_t)NB * 2 * 64 * CL * 2 <= WS_YMOE && WS_YMOE + (size_t)MPAD * D <= WS_END, "ws map moe");
constexpr int CW_BAR = 4096;
constexpr int CW_ECNT = 8192;
constexpr int CW_CTXIN = 16384;
constexpr int CW_SCANX = 32768;
constexpr int CW_BGQ = 24576;
constexpr int CW_CTXMIX = 12288;

constexpr int LDS_BYTES = 148480;
constexpr int TOKTAB_OFF = 131072;
constexpr int ROPE_OFF = 131072;
constexpr int MISC_OFF = 131072 + 16384;

DI unsigned f2bf(float f) { unsigned u = __float_as_uint(f); return (u + 0x7fffu + ((u >> 16) & 1u)) >> 16; }
DI unsigned pk2(float lo, float hi) { unsigned r; asm("v_cvt_pk_bf16_f32 %0, %1, %2" : "=v"(r) : "v"(lo), "v"(hi)); return r; }
typedef _Float16 f16x2 __attribute__((ext_vector_type(2)));
DI unsigned pkh2(float lo, float hi) { const f16x2 t = {(_Float16)lo, (_Float16)hi}; return __builtin_bit_cast(unsigned, t); }
DI f32x2 unpkh2(unsigned u) { const f16x2 t = __builtin_bit_cast(f16x2, u); return (f32x2){(float)t.x, (float)t.y}; }
DI float bf_lo(unsigned u) { return __uint_as_float(u << 16); }
DI float bf_hi(unsigned u) { return __uint_as_float(u & 0xffff0000u); }
DI float bf2f(bf16_t b) { return __uint_as_float(((unsigned)b) << 16); }
template <int CTRL, int ROWMASK = 0xf> DI float dpp_mov(float v) { return __builtin_bit_cast(float, __builtin_amdgcn_update_dpp(0, __builtin_bit_cast(int, v), CTRL, ROWMASK, 0xf, ROWMASK == 0xf)); }
DI float wave_sum(float v) {
    v += dpp_mov<0xB1>(v); v += dpp_mov<0x4E>(v); v += dpp_mov<0x141>(v); v += dpp_mov<0x140>(v);
    v += dpp_mov<0x142, 0xa>(v); v += dpp_mov<0x143, 0xc>(v);
    return __builtin_bit_cast(float, __builtin_amdgcn_readlane(__builtin_bit_cast(int, v), 63));
}
DI float xor32_max(float v) { float a = v, b = v; asm("s_nop 1\n\tv_permlane32_swap_b32 %0, %1" : "+v"(a), "+v"(b)); return fmaxf(a, b); }
DI float xor32_sum(float v) { float a = v, b = v; asm("s_nop 1\n\tv_permlane32_swap_b32 %0, %1" : "+v"(a), "+v"(b)); return a + b; }
DI int lane_id_v() { int l; asm volatile("v_mbcnt_lo_u32_b32 %0, -1, 0\n\tv_mbcnt_hi_u32_b32 %0, -1, %0" : "=v"(l)); return l; }
DI void lds_barrier() { asm volatile("s_waitcnt lgkmcnt(0)" ::: "memory"); __builtin_amdgcn_s_barrier(); asm volatile("" ::: "memory"); }
DI float f8clamp(float x) { return __builtin_amdgcn_fmed3f(x, -448.0f, 448.0f); }
DI float fast_exp2(float x) { return __builtin_amdgcn_exp2f(x); }
DI float fast_rcp(float x) { return __builtin_amdgcn_rcpf(x); }
DI float sigmoidf_(float x) { return fast_rcp(1.0f + fast_exp2(-x * LOG2E)); }
DI float gelu_tanh(float x) {
    const float u = 0.7978845608028654f * (x + 0.044715f * x * x * x);
    return x * sigmoidf_(2.0f * u);
}

DI unsigned swap1(unsigned v) { return (unsigned)__builtin_amdgcn_update_dpp(0, (int)v, 0xB1, 0xf, 0xf, true); }
DI u32x4 swap1(u32x4 v) { return (u32x4){swap1(v.x), swap1(v.y), swap1(v.z), swap1(v.w)}; }
DI u32x2 swap1(u32x2 v) { return (u32x2){swap1(v.x), swap1(v.y)}; }
DI int wblk(int nb) { return (nb & ~7) | ((nb & 1) * 4 + ((nb >> 1) & 3)); }

#define XB_TMO      128
#define XB_XCNT(j)  (256  + 64 * (j))
#define XB_XSUB(j)  (1280 + 64 * (j))
#define XB_XGEN(j)  (2304 + 64 * (j))
#define XB_TOP      3328
#define XB_TOPGEN   3392
#define XCD_BAR_WORDS 3456
#define XB_SPIN_CAP (1u << 18)

__device__ __forceinline__ unsigned xb_ld(unsigned* p)              { return __hip_atomic_load(p, __ATOMIC_RELAXED, __HIP_MEMORY_SCOPE_AGENT); }
__device__ __forceinline__ unsigned xb_add(unsigned* p, unsigned v) { return __hip_atomic_fetch_add(p, v, __ATOMIC_RELAXED, __HIP_MEMORY_SCOPE_AGENT); }
__device__ __forceinline__ unsigned xb_xcc_id() { return (unsigned)__builtin_amdgcn_s_getreg((3 << 11) | 20) & 0xFu; }
#define XB_SPIN(cond, bar) do { unsigned _sp = 0; while (cond) { __builtin_amdgcn_s_sleep(1); \
    if ((++_sp & 255u) == 0u) { if (xb_ld(&(bar)[XB_TMO])) break; if (_sp > XB_SPIN_CAP) { atomicAdd(&(bar)[XB_TMO], 1u); break; } } } } while (0)

struct XcdBarrier { unsigned* bar; unsigned x; volatile LAS unsigned* st; };

__device__ __forceinline__ XcdBarrier xcd_barrier_post(unsigned* bar, volatile LAS unsigned* st, const bool leader) {
    XcdBarrier b; b.bar = bar; b.x = xb_xcc_id(); b.st = st;
    if (leader) (void)xb_add(&bar[XB_XCNT(b.x)], 1u);
    return b;
}
__device__ __forceinline__ void xcd_barrier_complete(unsigned* bar, unsigned x, unsigned& nloc, unsigned& nx) {
    const unsigned G = gridDim.x * gridDim.y * gridDim.z;
    unsigned sum, cnt, mine, sp = 0u;
    for (;;) {
        sum = 0u; cnt = 0u; mine = 0u;
        unsigned cv[16];
#pragma unroll
        for (unsigned j = 0; j < 16; ++j) asm volatile("global_load_dword %0, %1, off sc1" : "=v"(cv[j]) : "v"(&bar[XB_XCNT(j)]) : "memory");
        asm volatile("s_waitcnt vmcnt(0)" : "+v"(cv[0]), "+v"(cv[1]), "+v"(cv[2]), "+v"(cv[3]), "+v"(cv[4]), "+v"(cv[5]), "+v"(cv[6]), "+v"(cv[7]), "+v"(cv[8]), "+v"(cv[9]), "+v"(cv[10]), "+v"(cv[11]), "+v"(cv[12]), "+v"(cv[13]), "+v"(cv[14]), "+v"(cv[15]) :: "memory");
#pragma unroll
        for (unsigned j = 0; j < 16; ++j) { const unsigned c = cv[j]; sum += c; cnt += (c > 0u) ? 1u : 0u; mine = (j == x) ? c : mine; }
        if (sum == G) break;
        __builtin_amdgcn_s_sleep(1);
        if ((++sp & 255u) == 0u) { if (xb_ld(&bar[XB_TMO])) break; if (sp > XB_SPIN_CAP) { atomicAdd(&bar[XB_TMO], 1u); break; } }
    }
    nloc = mine > 0u ? mine : 1u; nx = cnt > 0u ? cnt : 1u;
}
__device__ __forceinline__ void xcd_barrier(const XcdBarrier& b, const bool leader) {
    asm volatile("s_waitcnt vmcnt(0)" ::: "memory");
    __syncthreads();
    if (leader) {
        unsigned* bar = b.bar;
        __builtin_amdgcn_s_waitcnt(0);
        unsigned nloc = b.st[0], nx = b.st[1];
        if (nloc == 0u) { xcd_barrier_complete(bar, b.x, nloc, nx); b.st[0] = nloc; b.st[1] = nx; }
        const unsigned old = xb_add(&bar[XB_XSUB(b.x)], 1u);
        const unsigned gen = old / nloc;
        if (old + 1u == (gen + 1u) * nloc) {
            __builtin_amdgcn_fence(__ATOMIC_RELEASE, "agent");
            asm volatile("s_waitcnt vmcnt(0)" ::: "memory");
            const unsigned og = xb_add(&bar[XB_TOP], 1u);
            const unsigned tg = og / nx;
            if (og + 1u == (tg + 1u) * nx) xb_add(&bar[XB_TOPGEN], 1u);
            else XB_SPIN(xb_ld(&bar[XB_TOPGEN]) == tg, bar);
            __builtin_amdgcn_fence(__ATOMIC_ACQUIRE, "agent");
            xb_add(&bar[XB_XGEN(b.x)], 1u);
            asm volatile("s_waitcnt vmcnt(0)" ::: "memory");
        } else {
            XB_SPIN(xb_ld(&bar[XB_XGEN(b.x)]) == gen, bar);
            __builtin_amdgcn_fence(__ATOMIC_ACQUIRE, "agent");
            asm volatile("s_waitcnt vmcnt(0)" ::: "memory");
        }
    }
    __syncthreads();
}

namespace pg8 {
constexpr int BM = 256, BK = 64, HALF = 128, HTB = HALF * BK * 2, STAGE_BYTES = 8 * HTB, NXCD = 8, WGM = 8;
__host__ __device__ __forceinline__ int lds_byte(int r, int c) { const int st = (r >> 4) * 2 + (c >> 5), rr = r & 15, cc = c & 31, ob = rr * 64 + cc * 2; return st * 1024 + (ob ^ (((ob >> 9) & 1) << 5)); }
__host__ __device__ __forceinline__ void stage_rc(int b, int& R, int& C) { const int st = b / 1024, sb = b % 1024, swz = sb ^ (((sb >> 9) & 1) << 5); R = (st >> 1) * 16 + swz / 64; C = (st & 1) * 32 + (swz % 64) / 2; }

struct Unit { int pm, pn; };

struct StaticOrder {
    static constexpr bool GATHER = false;
    int nM, nN, nwg, G, c, K;
    __device__ __forceinline__ void init(int M, int N, int K_, int G_, int c_) { nM = M / BM; nN = N / BM; nwg = nM * nN; G = G_; c = c_; K = K_; }
    __device__ __forceinline__ bool next(int i, Unit& u) const {
        const long L = (long)i * G + c; if (L >= nwg) return false;
        int wgid = (int)L; { const int q = nwg / NXCD, r = nwg % NXCD, xcd = wgid % NXCD, off = wgid / NXCD; wgid = (xcd < r ? xcd * (q + 1) : r * (q + 1) + (xcd - r) * q) + off; }
        const int nig = WGM * nN, gid = wgid / nig, fm = gid * WGM, gsz = (nM - fm) < WGM ? (nM - fm) : WGM;
        u.pm = fm + ((wgid % nig) % gsz); u.pn = (wgid % nig) / gsz; return true;
    }
    __device__ __forceinline__ size_t b_off(const Unit& u) const { return (size_t)u.pn * BM * K * 2; }
    __device__ __forceinline__ LAS const int* tok(int) const { return nullptr; }
};
struct OneUnit {
    static constexpr bool GATHER = false; int pm, pn, K;
    __device__ __forceinline__ bool next(int i, Unit& u) const { if (i != 0) return false; u.pm = pm; u.pn = pn; return true; }
    __device__ __forceinline__ size_t b_off(const Unit& u) const { return (size_t)u.pn * BM * K * 2; }
    __device__ __forceinline__ LAS const int* tok(int) const { return nullptr; }
};
template <bool GATHER_> struct MoeOrder {
    static constexpr bool GATHER = GATHER_;
    int ntiles, nN, G, c, K; const int* tile_e; size_t estride; LAS const int* toktab;
    __device__ __forceinline__ bool next(int i, Unit& u) const { const long L = (long)i * G + c; if (L >= (long)ntiles * nN) return false; u.pm = (int)(L / nN); u.pn = (int)(L % nN); return true; }
    __device__ __forceinline__ size_t b_off(const Unit& u) const { return (size_t)__builtin_amdgcn_readfirstlane(tile_e[u.pm]) * estride + (size_t)u.pn * BM * K * 2; }
    __device__ __forceinline__ LAS const int* tok(int ui) const { return toktab + ui * 256; }
};

typedef int i32x8 __attribute__((ext_vector_type(8)));
typedef _Float16 f16x8 __attribute__((ext_vector_type(8)));
typedef int i32x4 __attribute__((ext_vector_type(4)));
template <class Epi, class Sched, bool FP8 = false, bool F16 = false>
__device__ __forceinline__ void gemm_phase(LAS unsigned char* lds, const int tid, const bf16_t* Ap, const bf16_t* Btp, const int K, const Sched& S, const Epi& E) {
    const int wid = __builtin_amdgcn_readfirstlane(tid >> 6), lane = tid & 63, wr = wid >> 2, wc = wid & 3, fr = lane & 15, fq = lane >> 4;
    const int nt = K / BK;
    unsigned voffA[2], voffB[2];
#pragma unroll
    for (int i = 0; i < 2; ++i) { int R, C; stage_rc(tid * 16 + i * 8192, R, C); voffA[i] = (unsigned)(R * K + C) * 2u; voffB[i] = voffA[i]; }
    unsigned gvC[2][2], gvN[2][2];
    const size_t kstep = (size_t)(BK * 2);
    const size_t hstep = (size_t)HALF * K * 2;
    const size_t tstep = 2 * hstep;
    const unsigned ldsw = (unsigned)wid * 1024u;
    const int aoff = lds_byte(wr * 64 + fr, fq * 8), boff = lds_byte(wc * 32 + fr, fq * 8);
#define PG8_SA(b, h) (((b) * 2 + (h)) * HTB)
#define PG8_SB(b, h) ((4 + (b) * 2 + (h)) * HTB)
#define PG8_STAGE2(bufoff, gbase, v0, v1) do { \
        __builtin_amdgcn_global_load_lds((const unsigned*)((const char*)(gbase) + (v0)), (LAS unsigned*)(lds + (bufoff) + ldsw), 16, 0, 0); \
        __builtin_amdgcn_global_load_lds((const unsigned*)((const char*)(gbase) + (v1)), (LAS unsigned*)(lds + (bufoff) + ldsw + 8192), 16, 0, 0); } while (0)
#define PG8_STAGEB(bufoff, gbase) PG8_STAGE2(bufoff, gbase, voffB[0], voffB[1])
#define PG8_STAGEA(bufoff, sel, h, kb) do { if constexpr (Sched::GATHER) { const unsigned _v0 = (sel) ? gvN[h][0] : gvC[h][0], _v1 = (sel) ? gvN[h][1] : gvC[h][1]; PG8_STAGE2(bufoff, (const char*)Ap + (kb), _v0, _v1); } \
        else { PG8_STAGE2(bufoff, ((sel) ? nA : cA) + (size_t)(h) * hstep + (kb), voffA[0], voffA[1]); } } while (0)
#define PG8_LDA(dst, b, h) do { _Pragma("unroll") for (int m = 0; m < 4; ++m) _Pragma("unroll") for (int k = 0; k < 2; ++k) dst[m][k] = *(const LAS bf16x8*)(lds + PG8_SA(b, h) + aoff + m * 2048 + k * 1024); } while (0)
#define PG8_LDB(dst, b, h) do { _Pragma("unroll") for (int n = 0; n < 2; ++n) _Pragma("unroll") for (int k = 0; k < 2; ++k) dst[n][k] = *(const LAS bf16x8*)(lds + PG8_SB(b, h) + boff + n * 2048 + k * 1024); } while (0)
#define PG8_CAT8(x0, x1) __builtin_shufflevector(__builtin_bit_cast(i32x4, x0), __builtin_bit_cast(i32x4, x1), 0, 1, 2, 3, 4, 5, 6, 7)
#define PG8_MMA(ai, bj, At, Bt) do { __builtin_amdgcn_s_setprio(1); if constexpr (FP8) { _Pragma("unroll") for (int m = 0; m < 4; ++m) _Pragma("unroll") for (int n = 0; n < 2; ++n) { \
            const i32x8 _a = PG8_CAT8(Bt[n][0], Bt[n][1]), _b = PG8_CAT8(At[m][0], At[m][1]); \
            asm volatile("v_mfma_scale_f32_16x16x128_f8f6f4 %0, %1, %2, %0, %3, %3 op_sel_hi:[0,0,0]" : "+v"(acc[ai][bj][m][n]) : "v"(_a), "v"(_b), "v"(f8one)); } }   \
        else if constexpr (F16) { _Pragma("unroll") for (int m = 0; m < 4; ++m) _Pragma("unroll") for (int n = 0; n < 2; ++n) _Pragma("unroll") for (int k = 0; k < 2; ++k) \
        acc[ai][bj][m][n] = __builtin_amdgcn_mfma_f32_16x16x32_f16(__builtin_bit_cast(f16x8, Bt[n][k]), __builtin_bit_cast(f16x8, At[m][k]), acc[ai][bj][m][n], 0, 0, 0); } \
        else { _Pragma("unroll") for (int m = 0; m < 4; ++m) _Pragma("unroll") for (int n = 0; n < 2; ++n) _Pragma("unroll") for (int k = 0; k < 2; ++k) \
        acc[ai][bj][m][n] = __builtin_amdgcn_mfma_f32_16x16x32_bf16(Bt[n][k], At[m][k], acc[ai][bj][m][n], 0, 0, 0); } __builtin_amdgcn_s_setprio(0); } while (0)
#define PG8_WAIT_V(n) asm volatile("s_waitcnt vmcnt(" #n ")" ::: "memory")
#define PG8_WAIT_L(n) asm volatile("s_waitcnt lgkmcnt(" #n ")" ::: "memory")
#define PG8_BAR __builtin_amdgcn_s_barrier()
#define PG8_SCHED __builtin_amdgcn_sched_barrier(0)
#define PG8_GV(dst, ui_) do { if constexpr (Sched::GATHER) { LAS const int* _tt = S.tok(ui_); _Pragma("unroll") for (int _h = 0; _h < 2; ++_h) _Pragma("unroll") for (int _i = 0; _i < 2; ++_i) \
        { int _R, _C; stage_rc(tid * 16 + _i * 8192, _R, _C); dst[_h][_i] = ((unsigned)_tt[_h * 128 + _R] * (unsigned)K + (unsigned)_C) * 2u; } } } while (0)
    Unit cur, nxt; int ui = 0;
    if (!S.next(0, cur)) return;
    int f8one = 0x7f7f7f7f; asm volatile("" : "+v"(f8one));
    f32x4 acc[2][2][4][2];
#pragma unroll
    for (int a = 0; a < 2; ++a)
#pragma unroll
        for (int b = 0; b < 2; ++b)
#pragma unroll
            for (int m = 0; m < 4; ++m)
#pragma unroll
                for (int n = 0; n < 2; ++n) acc[a][b][m][n] = (f32x4){0.f, 0.f, 0.f, 0.f};
    bf16x8 At[4][2], B0[2][2], B1[2][2];
    const char* cA = (const char*)Ap + (size_t)cur.pm * tstep; const char* cB = (const char*)Btp + S.b_off(cur);
    const char* nA = cA; const char* nB = cB;
    PG8_GV(gvC, 0);
#pragma unroll
    for (int _h = 0; _h < 2; ++_h) { gvN[_h][0] = gvC[_h][0]; gvN[_h][1] = gvC[_h][1]; }
    asm volatile("" ::: "memory");
    PG8_STAGEB(PG8_SB(0, 0), cB); PG8_STAGEA(PG8_SA(0, 0), false, 0, 0); PG8_STAGEB(PG8_SB(0, 1), cB + hstep); PG8_STAGEA(PG8_SA(0, 1), false, 1, 0);
    if (wr == 1) PG8_BAR;
    PG8_WAIT_V(4); PG8_BAR;
    PG8_STAGEB(PG8_SB(1, 0), cB + kstep); PG8_STAGEA(PG8_SA(1, 0), false, 0, kstep); PG8_STAGEB(PG8_SB(1, 1), cB + hstep + kstep);
    PG8_WAIT_V(6); PG8_BAR;
    for (;;) {
        const bool has_next = S.next(ui + 1, nxt);
        nA = has_next ? (const char*)Ap + (size_t)nxt.pm * tstep : cA; nB = has_next ? (const char*)Btp + S.b_off(nxt) : cB;
        if (has_next) { PG8_GV(gvN, ui + 1); }
#pragma unroll 1
        for (int t = 0; t < nt; t += 2) {
            const bool last = (t == nt - 2);
            const size_t k1 = (size_t)(t + 1) * kstep;
            const size_t k2 = last ? 0 : (size_t)(t + 2) * kstep;
            const char* b2 = last ? nB : cB + (size_t)(t + 2) * kstep;
            const size_t k3 = k2 + kstep; const char* b3 = b2 + kstep;
            PG8_LDB(B0, 0, 0); PG8_SCHED; PG8_LDA(At, 0, 0); PG8_STAGEA(PG8_SA(1, 1), false, 1, k1);
            PG8_WAIT_L(8); PG8_BAR; PG8_WAIT_L(0); PG8_MMA(0, 0, At, B0); PG8_BAR; PG8_SCHED;
            PG8_LDB(B1, 0, 1); PG8_STAGEB(PG8_SB(0, 0), b2);
            PG8_BAR; PG8_WAIT_L(0); PG8_MMA(0, 1, At, B1); PG8_BAR;
            PG8_LDA(At, 0, 1); PG8_STAGEA(PG8_SA(0, 0), last, 0, k2);
            PG8_BAR; PG8_WAIT_L(0); PG8_MMA(1, 0, At, B0); PG8_BAR; PG8_SCHED;
            PG8_STAGEB(PG8_SB(0, 1), b2 + hstep);
            PG8_WAIT_V(6); PG8_BAR; PG8_MMA(1, 1, At, B1); PG8_BAR;
            PG8_LDB(B0, 1, 0); PG8_SCHED; PG8_LDA(At, 1, 0); PG8_STAGEA(PG8_SA(0, 1), last, 1, k2);
            PG8_WAIT_L(8); PG8_BAR; PG8_WAIT_L(0); PG8_MMA(0, 0, At, B0); PG8_BAR; PG8_SCHED;
            PG8_LDB(B1, 1, 1); PG8_STAGEB(PG8_SB(1, 0), b3);
            PG8_BAR; PG8_WAIT_L(0); PG8_MMA(0, 1, At, B1); PG8_BAR;
            PG8_LDA(At, 1, 1); PG8_STAGEA(PG8_SA(1, 0), last, 0, k3);
            PG8_BAR; PG8_WAIT_L(0); PG8_MMA(1, 0, At, B0); PG8_BAR; PG8_SCHED;
            PG8_STAGEB(PG8_SB(1, 1), b3 + hstep);
            PG8_WAIT_V(6); PG8_BAR; PG8_MMA(1, 1, At, B1); PG8_BAR;
        }
        if constexpr (FP8) asm volatile("s_nop 15\n\ts_nop 15" ::: "memory");
        E(acc, cur, wr, wc, fr, fq);
        if (!has_next) break;
#pragma unroll
        for (int a = 0; a < 2; ++a)
#pragma unroll
            for (int b = 0; b < 2; ++b)
#pragma unroll
                for (int m = 0; m < 4; ++m)
#pragma unroll
                    for (int n = 0; n < 2; ++n) acc[a][b][m][n] = (f32x4){0.f, 0.f, 0.f, 0.f};
        cur = nxt; cA = nA; cB = nB; ++ui;
#pragma unroll
        for (int _h = 0; _h < 2; ++_h) { gvC[_h][0] = gvN[_h][0]; gvC[_h][1] = gvN[_h][1]; }
    }
    PG8_WAIT_V(0);
    if (wr == 0) PG8_BAR;
    PG8_BAR;
#undef PG8_SA
#undef PG8_SB
#undef PG8_STAGE2
#undef PG8_STAGEA
#undef PG8_STAGEB
#undef PG8_LDA
#undef PG8_LDB
#undef PG8_MMA
#undef PG8_CAT8
#undef PG8_WAIT_V
#undef PG8_WAIT_L
#undef PG8_BAR
#undef PG8_SCHED
#undef PG8_GV
}

struct EpiPlainBf16 {
    bf16_t* O; int ldc; float scale;
    DI void operator()(const f32x4 (&acc)[2][2][4][2], const Unit& u, int wr, int wc, int fr, int fq) const {
        const int odd = fr & 1; const int rowb = u.pm * BM + wr * 64 + (fr - odd), colb = u.pn * BM + wc * 64 + odd * 32 + 8 * fq;
#pragma unroll
        for (int ai = 0; ai < 2; ++ai)
#pragma unroll
            for (int m = 0; m < 4; ++m) { u32x4 X[2];
#pragma unroll
                for (int bj = 0; bj < 2; ++bj) { const f32x4 v0 = acc[ai][bj][m][0] * scale, v1 = acc[ai][bj][m][1] * scale; X[bj].x = pk2(v0[0], v0[1]); X[bj].y = pk2(v0[2], v0[3]); X[bj].z = pk2(v1[0], v1[1]); X[bj].w = pk2(v1[2], v1[3]); }
                const u32x4 recv = swap1(odd ? X[0] : X[1]);
                bf16_t* rowp = O + (size_t)(rowb + ai * HALF + m * 16) * ldc + colb;
                *(u32x4*)rowp = odd ? recv : X[0]; *(u32x4*)(rowp + ldc) = odd ? X[1] : recv; }
    }
};
constexpr float F8_SY = 16.0f;
struct EpiPlainF8 {
    unsigned char* O; int ldc; float scale;
    DI void operator()(const f32x4 (&acc)[2][2][4][2], const Unit& u, int wr, int wc, int fr, int fq) const {
        const int odd = fr & 1; const int rowb = u.pm * BM + wr * 64 + (fr - odd), colb = u.pn * BM + wc * 64 + odd * 32 + 8 * fq;
#pragma unroll
        for (int ai = 0; ai < 2; ++ai)
#pragma unroll
            for (int m = 0; m < 4; ++m) { u32x2 X[2];
#pragma unroll
                for (int bj = 0; bj < 2; ++bj) { f32x4 v0 = acc[ai][bj][m][0] * scale, v1 = acc[ai][bj][m][1] * scale;
#pragma unroll
                    for (int j = 0; j < 4; ++j) { v0[j] = f8clamp(v0[j]); v1[j] = f8clamp(v1[j]); }
                    X[bj].x = (unsigned)__builtin_amdgcn_cvt_pk_fp8_f32(v0[0], v0[1], 0, false); X[bj].x = (unsigned)__builtin_amdgcn_cvt_pk_fp8_f32(v0[2], v0[3], (int)X[bj].x, true);
                    X[bj].y = (unsigned)__builtin_amdgcn_cvt_pk_fp8_f32(v1[0], v1[1], 0, false); X[bj].y = (unsigned)__builtin_amdgcn_cvt_pk_fp8_f32(v1[2], v1[3], (int)X[bj].y, true); }
                const u32x2 recv = swap1(odd ? X[0] : X[1]);
                unsigned char* rowp = O + (size_t)(rowb + ai * HALF + m * 16) * ldc + colb;
                *(u32x2*)rowp = odd ? recv : X[0]; *(u32x2*)(rowp + ldc) = odd ? X[1] : recv; }
    }
};
struct EpiRouter {
    float* LOG;
    DI void operator()(const f32x4 (&acc)[2][2][4][2], const Unit& u, int wr, int wc, int fr, int fq) const {
        if (u.pn != 0 || wc >= 2) return;
        const int row0 = u.pm * BM + wr * 64 + fr, col0 = wc * 32 + 4 * fq;
#pragma unroll
        for (int ai = 0; ai < 2; ++ai)
#pragma unroll
            for (int m = 0; m < 4; ++m) { float* rowp = LOG + (size_t)(row0 + ai * HALF + m * 16) * 64 + col0;
#pragma unroll
                for (int n = 0; n < 2; ++n) *(f32x4*)(rowp + n * 16) = acc[ai][0][m][n]; }
    }
};
constexpr float F8_SW13 = 32.0f, F8_SH = 8.0f, F8_SW2 = 64.0f;
struct EpiSwigluF8 {
    unsigned char* H;
    DI void operator()(const f32x4 (&acc)[2][2][4][2], const Unit& u, int wr, int wc, int fr, int fq) const {
        const int row0 = u.pm * BM + wr * 64 + fr, col0 = u.pn * 128 + wc * 32 + 8 * fq;
#pragma unroll
        for (int ai = 0; ai < 2; ++ai)
#pragma unroll
            for (int m = 0; m < 4; ++m) { unsigned char* rowp = H + (size_t)(row0 + ai * HALF + m * 16) * DE + col0; float o[8];
#pragma unroll
                for (int n = 0; n < 2; ++n) { const f32x4 a = acc[ai][0][m][n], b = acc[ai][1][m][n] * (F8_SH / (F8_SW13 * F8_SW13));
#pragma unroll
                    for (int j = 0; j < 4; ++j) o[4 * n + j] = f8clamp(a[j] * b[j] * fast_rcp(1.0f + fast_exp2(a[j] * (-LOG2E / F8_SW13)))); }
                u32x2 w; w.x = (unsigned)__builtin_amdgcn_cvt_pk_fp8_f32(o[0], o[1], 0, false); w.x = (unsigned)__builtin_amdgcn_cvt_pk_fp8_f32(o[2], o[3], (int)w.x, true);
                w.y = (unsigned)__builtin_amdgcn_cvt_pk_fp8_f32(o[4], o[5], 0, false); w.y = (unsigned)__builtin_amdgcn_cvt_pk_fp8_f32(o[6], o[7], (int)w.y, true);
                *(u32x2*)(rowp) = w; }
    }
};
struct EpiInproj {
    bf16_t *U, *Gt, *Q, *Kb, *Vt, *Vtc; const LAS float* rope;
    DI void operator()(const f32x4 (&acc)[2][2][4][2], const Unit& u, int wr, int wc, int fr, int fq) const {
        const int row0 = u.pm * BM + wr * 64 + fr;
        const bool lat = u.pm < (NLAT / BM);
        if (u.pn < 4) {
            bf16_t* base = (u.pn < 2) ? U : Gt; const int odd = fr & 1; const int colb = (u.pn & 1) * 256 + wc * 64 + odd * 32 + 8 * fq;
#pragma unroll
            for (int ai = 0; ai < 2; ++ai)
#pragma unroll
                for (int m = 0; m < 4; ++m) { u32x4 X[2];
#pragma unroll
                    for (int bj = 0; bj < 2; ++bj) { const f32x4 v0 = acc[ai][bj][m][0], v1 = acc[ai][bj][m][1]; X[bj].x = pk2(v0[0], v0[1]); X[bj].y = pk2(v0[2], v0[3]); X[bj].z = pk2(v1[0], v1[1]); X[bj].w = pk2(v1[2], v1[3]); }
                    const u32x4 recv = swap1(odd ? X[0] : X[1]);
                    bf16_t* rowp = base + (size_t)(row0 - odd + ai * HALF + m * 16) * DR + colb;
                    *(u32x4*)rowp = odd ? recv : X[0]; *(u32x4*)(rowp + DR) = odd ? X[1] : recv; }
        } else {
            const bool isq = u.pn < 6;
            const float sc = isq ? 0.125f * LOG2E : 1.0f;
#pragma unroll
            for (int ai = 0; ai < 2; ++ai)
#pragma unroll
                for (int m = 0; m < 4; ++m) {
                    const int r = row0 + ai * HALF + m * 16;
                    f32x4 cs = (f32x4){1.f, 1.f, 1.f, 1.f}, sn = (f32x4){0.f, 0.f, 0.f, 0.f};
                    if (lat) { const int s = r & (SEQ - 1); const int pos = (wc & 1) ? (s & 63) : (s >> 6); cs = *(const LAS f32x4*)(rope + pos * 32 + 4 * fq); sn = *(const LAS f32x4*)(rope + pos * 32 + 16 + 4 * fq); }
                    cs = cs * sc; sn = sn * sc;
                    if (isq) {
                        bf16_t* rowp = Q + (size_t)r * 512 + (u.pn - 4) * 256 + wc * 32 + 4 * fq;
#pragma unroll
                        for (int bj = 0; bj < 2; ++bj) { const f32x4 x1 = acc[ai][bj][m][0], x2 = acc[ai][bj][m][1]; const f32x4 o1 = x1 * cs - x2 * sn, o2 = x2 * cs + x1 * sn;
                            u32x2 w; w.x = pk2(o1[0], o1[1]); w.y = pk2(o1[2], o1[3]); *(u32x2*)(rowp + bj * HALF) = w;
                            w.x = pk2(o2[0], o2[1]); w.y = pk2(o2[2], o2[3]); *(u32x2*)(rowp + bj * HALF + 16) = w; }
                    } else {
                        { bf16_t* rowp = Kb + (size_t)r * 128 + wc * 32 + 4 * fq;
                          const f32x4 x1 = acc[ai][0][m][0], x2 = acc[ai][0][m][1]; const f32x4 o1 = x1 * cs - x2 * sn, o2 = x2 * cs + x1 * sn;
                          u32x2 w; w.x = pk2(o1[0], o1[1]); w.y = pk2(o1[2], o1[3]); *(u32x2*)(rowp) = w;
                          w.x = pk2(o2[0], o2[1]); w.y = pk2(o2[2], o2[3]); *(u32x2*)(rowp + 16) = w; }
                        const int kvh = wc >> 1; bf16_t* vb; size_t ldv;
                        const int rp = (r & ~15) | (r & 3) | ((r & 4) << 1) | ((r & 8) >> 1);
                        if (lat) { const int b = rp >> 13, s = rp & (SEQ - 1); vb = Vt + ((size_t)(b * 2 + kvh) * 64) * SEQ + s; ldv = SEQ; }
                        else { const int rc = rp - NLAT; const int b = rc >> 8, c = rc & (CL - 1); vb = Vtc + ((size_t)(b * 2 + kvh) * 64) * CL + c; ldv = CL; }
#pragma unroll
                        for (int n = 0; n < 2; ++n)
#pragma unroll
                            for (int j = 0; j < 4; ++j) { const int d = 32 * (wc & 1) + 16 * n + 4 * fq + j; vb[(size_t)d * ldv] = (bf16_t)f2bf(acc[ai][1][m][n][j]); }
                    }
                }
        }
    }
};
}

struct Params { const float* in[29]; float* out; unsigned char* ws; int ph_lo, ph_hi; };
enum { I_X = 0, I_C, I_CTX, I_CCTX, I_WMOD, I_BMOD, I_WIN, I_CONVW, I_CONVB, I_RGWA, I_RGBA, I_RGWX, I_RGBX, I_RGLAM, I_SINK, I_GNR, I_GNA, I_WOUT,
       I_LN1G, I_LN1B, I_RTG, I_RTGB, I_RTE, I_RTEB, I_W1, I_W3, I_W2, I_LN2G, I_LN2B };

typedef const __attribute__((address_space(4))) Params* PP;
DI const float* gin(PP p, int i) { return (const float*)(const GAS float*)p->in[i]; }
struct Ctx {
    LAS unsigned char* lds; int tid, lane, wave, vcu, G, bx; unsigned char* ws; float* out;
};

template <bool PERM> DI void p0_transpose_item(const float* W, int K, int N, int k0, int n0, bf16_t* dst0, LAS float* scr, int lane) {
    f32x4 v[8];
#pragma unroll
    for (int i = 0; i < 8; ++i) v[i] = *(const f32x4*)(W + (size_t)(k0 + 8 * i + (lane >> 3)) * N + n0 + 4 * (lane & 7));
#pragma unroll
    for (int i = 0; i < 8; ++i) { LAS float* d = scr + (8 * i + (lane >> 3)) * 33 + 4 * (lane & 7); d[0] = v[i][0]; d[1] = v[i][1]; d[2] = v[i][2]; d[3] = v[i][3]; }
    asm volatile("s_waitcnt lgkmcnt(0)" ::: "memory");
    const int c = lane & 7;
#pragma unroll
    for (int j = 0; j < 4; ++j) { const int n = (lane >> 3) + 8 * j; const LAS float* s = scr + (8 * c) * 33 + n;
        u32x4 o; o.x = pk2(s[0 * 33], s[1 * 33]); o.y = pk2(s[2 * 33], s[3 * 33]); o.z = pk2(s[4 * 33], s[5 * 33]); o.w = pk2(s[6 * 33], s[7 * 33]);
        const int nd = PERM ? (16 * ((n >> 2) & 1) + 4 * (n >> 3) + (n & 3)) : n;
        *(u32x4*)(dst0 + (size_t)nd * K + k0 + 8 * c) = o; }
    asm volatile("s_waitcnt lgkmcnt(0)" ::: "memory");
}

DI void p0_transpose_item_f8(const float* W, int N, int k0, int n0, unsigned char* dst0, int Kb, float sc, LAS float* scr, int lane) {
    f32x4 v[8];
#pragma unroll
    for (int i = 0; i < 8; ++i) v[i] = *(const f32x4*)(W + (size_t)(k0 + 8 * i + (lane >> 3)) * N + n0 + 4 * (lane & 7));
#pragma unroll
    for (int i = 0; i < 8; ++i) { LAS float* d = scr + (8 * i + (lane >> 3)) * 33 + 4 * (lane & 7); d[0] = v[i][0]; d[1] = v[i][1]; d[2] = v[i][2]; d[3] = v[i][3]; }
    asm volatile("s_waitcnt lgkmcnt(0)" ::: "memory");
    const int c = lane & 3;
#pragma unroll
    for (int j = 0; j < 2; ++j) { const int n = (lane >> 2) + 16 * j; const LAS float* s = scr + (16 * c) * 33 + n; u32x4 o;
#pragma unroll
        for (int q = 0; q < 4; ++q) { int w = __builtin_amdgcn_cvt_pk_fp8_f32(f8clamp(s[(4 * q) * 33] * sc), f8clamp(s[(4 * q + 1) * 33] * sc), 0, false); w = __builtin_amdgcn_cvt_pk_fp8_f32(f8clamp(s[(4 * q + 2) * 33] * sc), f8clamp(s[(4 * q + 3) * 33] * sc), w, true); o[q] = (unsigned)w; }
        const int nd = 16 * ((n >> 2) & 1) + 4 * (n >> 3) + (n & 3);
        *(u32x4*)(dst0 + (size_t)nd * Kb + k0 + 16 * c) = o; }
    asm volatile("s_waitcnt lgkmcnt(0)" ::: "memory");
}

constexpr int MOE_ITEMS = 3 * 32 * 256;
DI void moe_weight_item(const Ctx& F, PP p, int l, int r, LAS float* scr) {
    if (r < 2 * 8192) { const int which = r >> 13; r &= 8191; const int e = r >> 8, kb = (r & 255) >> 4, nb = r & 15; const int n0 = nb * 32;
        const int drow = (n0 >> 7) * 256 + which * 128 + (n0 & 127);
        p0_transpose_item_f8(gin(p, which ? I_W3 : I_W1) + ((size_t)l * NE + e) * 1024 * DE, DE, kb * 64, n0, (unsigned char*)(F.ws + WS_W13) + (((size_t)l * NE + e) * 1024 + drow) * 1024, 1024, pg8::F8_SW13, scr, F.lane); }
    else { r -= 2 * 8192; const int e = r >> 8, kb = (r & 255) >> 5, nb = r & 31;
        p0_transpose_item_f8(gin(p, I_W2) + ((size_t)l * NE + e) * DE * 1024, 1024, kb * 64, nb * 32, (unsigned char*)(F.ws + WS_W2) + (((size_t)l * NE + e) * 1024 + wblk(nb) * 32) * DE, DE, pg8::F8_SW2, scr, F.lane); }
}
DI void bg_moe_weights(const Ctx& F, PP p, int l, int budget) {
    if (l >= DEPTH) return;
    unsigned* q = (unsigned*)(F.ws + WS_CTL) + CW_BGQ + l * 64; LAS float* scr = (LAS float*)(F.lds + F.wave * 16384);
    if (budget < 0) {
        const unsigned head = (unsigned)__builtin_amdgcn_readfirstlane((int)__hip_atomic_load(q, __ATOMIC_RELAXED, __HIP_MEMORY_SCOPE_AGENT));
        for (unsigned idx = head + (unsigned)(F.vcu * 8 + F.wave); idx < (unsigned)MOE_ITEMS; idx += (unsigned)(F.G * 8)) moe_weight_item(F, p, l, (int)idx, scr);
        return; }
    unsigned idx = 0; if (F.lane == 0) idx = __hip_atomic_fetch_add(q, (unsigned)budget, __ATOMIC_RELAXED, __HIP_MEMORY_SCOPE_AGENT);
    idx = (unsigned)__builtin_amdgcn_readfirstlane((int)idx);
    for (int n = 0; n < budget && idx + (unsigned)n < (unsigned)MOE_ITEMS; ++n) moe_weight_item(F, p, l, (int)(idx + (unsigned)n), scr);
}

DI void phase_prologue_a(const Ctx& F, PP p) {
    {
        LAS float* SC = (LAS float*)F.lds;
        LAS float* RED = (LAS float*)(F.lds + 36864);
        for (int i = F.tid; i < 9 * 1024; i += 512) { const int row = i >> 10, k = i & 1023; const float v = row < 8 ? gin(p, I_C)[row * 1024 + k] : gin(p, I_CCTX)[k]; SC[i] = v * sigmoidf_(v); }
        __syncthreads();
        float* MOD = (float*)(F.ws + WS_MOD);
        for (int it = F.vcu; it < 4 * 96; it += F.G) {
            const int l = it / 96, n = (it % 96) * 64 + F.lane;
            const float* wp = gin(p, I_WMOD) + (size_t)l * 1024 * 6144 + (size_t)(F.wave * 128) * 6144 + n;
            float acc[9];
#pragma unroll
            for (int r = 0; r < 9; ++r) acc[r] = 0.f;
            for (int k0 = 0; k0 < 128; k0 += 64) {
                float wv[64];
#pragma unroll
                for (int j = 0; j < 64; ++j) wv[j] = wp[(size_t)(k0 + j) * 6144];
#pragma unroll
                for (int j = 0; j < 64; ++j)
#pragma unroll
                    for (int r = 0; r < 9; ++r) acc[r] += SC[r * 1024 + F.wave * 128 + k0 + j] * wv[j];
            }
#pragma unroll
            for (int r = 0; r < 9; ++r) RED[(F.wave * 9 + r) * 64 + F.lane] = acc[r];
            __syncthreads();
            for (int i = F.tid; i < 9 * 64; i += 512) { const int r = i >> 6, c = i & 63; float s = 0.f;
#pragma unroll
                for (int w = 0; w < 8; ++w) s += RED[(w * 9 + r) * 64 + c];
                const int nn = (it % 96) * 64 + c; MOD[((size_t)l * 9 + r) * 6144 + nn] = s + gin(p, I_BMOD)[l * 6144 + nn]; }
            __syncthreads();
        }
    }
    if (F.vcu == 0) { float* rope = (float*)(F.ws + WS_ROPE);
        for (int i = F.tid; i < 128 * 16; i += 512) { const int pos = i >> 4, j = i & 15; const float inv = exp2f(-(float)(2 * j) * (13.287712379549449f / 32.0f)); const float ang = (float)pos * inv;
            rope[pos * 32 + j] = cosf(ang); rope[pos * 32 + 16 + j] = sinf(ang); } }
    { bf16_t* WR = (bf16_t*)(F.ws + WS_WR);
      for (int i = F.vcu * 512 + F.tid; i < 4 * 256 * 1024; i += F.G * 512) { const int l = i >> 18, n = (i >> 10) & 255, k = i & 1023; float v = 0.f;
          if (n < 4) v = gin(p, I_RTG)[((size_t)l * 1024 + k) * 4 + n]; else if (n < 36) v = gin(p, I_RTE)[((size_t)l * 1024 + k) * 32 + (n - 4)];
          WR[i] = (bf16_t)f2bf(v); } }
    {
        LAS float* scr = (LAS float*)(F.lds + F.wave * 16384);
        const int gw = F.vcu * 8 + F.wave, NGW = F.G * 8;
        constexpr int I_IN = 16 * 56, I_OUT = 16 * 32, PER_L = I_IN + I_OUT;
        for (int it = gw; it < 4 * PER_L + MOE_ITEMS; it += NGW) {
            if (it >= 4 * PER_L) { moe_weight_item(F, p, 0, it - 4 * PER_L, scr); continue; }
            const int l = it / PER_L; int r = it % PER_L;
            if (r < I_IN) { const int kb = r / 56, nb = r % 56; if (nb < 32) p0_transpose_item<true>(gin(p, I_WIN) + (size_t)l * 1024 * DIN, 1024, DIN, kb * 64, nb * 32, (bf16_t*)(F.ws + WS_WIN) + ((size_t)l * DIN + wblk(nb) * 32) * 1024, scr, F.lane); else p0_transpose_item<false>(gin(p, I_WIN) + (size_t)l * 1024 * DIN, 1024, DIN, kb * 64, nb * 32, (bf16_t*)(F.ws + WS_WIN) + ((size_t)l * DIN + nb * 32) * 1024, scr, F.lane); continue; } r -= I_IN;
            { const int kb = r / 32, nb = r % 32; p0_transpose_item<true>(gin(p, I_WOUT) + (size_t)l * 1024 * 1024, 1024, 1024, kb * 64, nb * 32, (bf16_t*)(F.ws + WS_WOUT) + ((size_t)l * 1024 + wblk(nb) * 32) * 1024, scr, F.lane); }
        }
    }
}

DI void router_fold_weights(const Ctx& F, PP p) {
    for (int it = F.vcu * 8 + F.wave; it < 4 * 8 * 36; it += F.G * 8) {
        const int l = it / 288, b = (it / 36) % 8, n = it % 36;
        const float* mod = (const float*)(F.ws + WS_MOD) + ((size_t)l * 9 + b) * 6144; const float* sh2 = mod + 3 * D; const float* sc2 = mod + 4 * D;
        _Float16* wd = (_Float16*)(F.ws + WS_WRB) + ((size_t)(l * 8 + b) * 64 + n) * 1024;
        float sn = 0.f, tn = 0.f;
#pragma unroll 4
        for (int j = 0; j < 16; ++j) { const int k = F.lane + 64 * j;
            const float w = (n < 4) ? gin(p, I_RTG)[((size_t)l * 1024 + k) * 4 + n] : gin(p, I_RTE)[((size_t)l * 1024 + k) * 32 + (n - 4)];
            const _Float16 wf = (_Float16)((1.0f + sc2[k]) * w); wd[k] = wf; sn += (float)wf; tn = __builtin_fmaf(sh2[k], w, tn); }
        sn = wave_sum(sn); tn = wave_sum(tn);
        if (F.lane == 0) { float* SN = (float*)(F.ws + WS_SNT) + (l * 8 + b) * 64 + n; SN[0] = sn; SN[4 * 8 * 64] = tn + ((n < 4) ? gin(p, I_RTGB)[l * 4 + n] : gin(p, I_RTEB)[l * 32 + (n - 4)]); }
    }
}

DI void row_stats(const f32x4 (&v)[4], float& mean, float& rstd) {
    float s = 0.f;
#pragma unroll
    for (int j = 0; j < 4; ++j) s += (v[j][0] + v[j][1]) + (v[j][2] + v[j][3]);
    mean = wave_sum(s) * (1.f / D); float q = 0.f;
#pragma unroll
    for (int j = 0; j < 4; ++j) { const f32x4 d = v[j] - mean; q += (d[0] * d[0] + d[1] * d[1]) + (d[2] * d[2] + d[3] * d[3]); }
    rstd = 1.0f / sqrtf(wave_sum(q) * (1.f / D) + LN_EPS);
}
DI void modulate_store(const f32x4 (&v)[4], const float* sh, const float* sc, bf16_t* orow, int lane) {
    float mean, rstd; row_stats(v, mean, rstd);
#pragma unroll
    for (int j = 0; j < 4; ++j) { const int c = 4 * lane + 256 * j; const f32x4 s1 = *(const f32x4*)(sc + c), s0 = *(const f32x4*)(sh + c);
        const f32x4 h = (v[j] - mean) * rstd * (s1 + 1.0f) + s0; u32x2 w; w.x = pk2(h[0], h[1]); w.y = pk2(h[2], h[3]); *(u32x2*)(orow + c) = w; }
}
DI const float* xrow_in(PP p, const Ctx& F, int l, int r) {
    if (l == 0) return r < NLAT ? gin(p, I_X) + (size_t)r * D : gin(p, I_CTX) + (size_t)(r - NLAT) * D;
    return r < NLAT ? F.out + (size_t)r * D : (const float*)(F.ws + WS_XC) + (size_t)(r - NLAT) * D;
}
DI float* xrow_out(const Ctx& F, int r) { return r < NLAT ? F.out + (size_t)r * D : (float*)(F.ws + WS_XC) + (size_t)(r - NLAT) * D; }

template <int MODE> struct RowBuf { u32x4 x[4]; u32x2 y[4]; u32x2 z[4]; float ga, gb; u32x2 sv; f32x2 gv; };
template <int MODE> DI void rows_slot_load(u32x2& sv, f32x2& gv, const Ctx& F, int r) {
    if (MODE == 2) { sv = *(const u32x2*)((const int*)(F.ws + WS_TOKR) + 2 * (size_t)r); gv = *(const f32x2*)((const float*)(F.ws + WS_TOKG) + 2 * (size_t)r); }
}
template <int MODE, bool SRC16> DI void rows_data_load(RowBuf<MODE>& R, const Ctx& F, PP p, int l, int r, const u32x2 sv, const f32x2 gv) {
    if (SRC16) { const unsigned short* xb = (const unsigned short*)(F.ws + WS_XB) + (size_t)r * D;
#pragma unroll
        for (int j = 0; j < 4; ++j) { const u32x2 t = *(const u32x2*)(xb + 4 * F.lane + 256 * j); R.x[j] = (u32x4){t.x, t.y, 0u, 0u}; }
    } else { const float* x = (MODE == 2) ? (const float*)xrow_out(F, r) : xrow_in(p, F, MODE == 0 ? 0 : l, r);
#pragma unroll
        for (int j = 0; j < 4; ++j) R.x[j] = *(const u32x4*)(x + 4 * F.lane + 256 * j); }
    if (MODE == 1) { const bf16_t* Y = (const bf16_t*)(F.ws + WS_Y) + (size_t)r * D;
#pragma unroll
        for (int j = 0; j < 4; ++j) R.y[j] = *(const u32x2*)(Y + 4 * F.lane + 256 * j); }
    if (MODE == 2) { const unsigned char* YM = F.ws + WS_YMOE; const unsigned char* ya = YM + (size_t)sv.x * D; const unsigned char* yb = YM + (size_t)sv.y * D; R.ga = gv.x * (1.0f / pg8::F8_SY); R.gb = gv.y * (1.0f / pg8::F8_SY);
#pragma unroll
        for (int j = 0; j < 4; ++j) { R.y[j] = (u32x2){*(const unsigned*)(ya + 4 * F.lane + 256 * j), 0u}; R.z[j] = (u32x2){*(const unsigned*)(yb + 4 * F.lane + 256 * j), 0u}; } }
}
struct RowVecs { f32x4 lg[4], lb[4], gg[4], sh[4], sc[4]; };
template <int MODE, bool SRC16, bool ISCTX, bool FEED, bool LASTOUT, bool HOC> DI void row_compute(const Ctx& F, const RowBuf<MODE>& R, const RowVecs& V, const int r, const bool valid, unsigned* ctxin) {
    unsigned char* const DUM = F.ws + WS_DUMMY;
    f32x4 v[4], xv[4];
    if (SRC16) {
#pragma unroll
        for (int j = 0; j < 4; ++j) { const f32x2 a = unpkh2(R.x[j].x), b2 = unpkh2(R.x[j].y); xv[j] = (f32x4){a.x, a.y, b2.x, b2.y}; }
    } else {
#pragma unroll
        for (int j = 0; j < 4; ++j) xv[j] = __builtin_bit_cast(f32x4, R.x[j]);
    }
    if (MODE == 0) {
#pragma unroll
        for (int j = 0; j < 4; ++j) v[j] = xv[j];
    } else {
#pragma unroll
        for (int j = 0; j < 4; ++j) { f32x4 yv;
            if (MODE == 2) { const f32x2 a0 = __builtin_amdgcn_cvt_pk_f32_fp8((int)R.y[j].x, false), a1 = __builtin_amdgcn_cvt_pk_f32_fp8((int)R.y[j].x, true), b0 = __builtin_amdgcn_cvt_pk_f32_fp8((int)R.z[j].x, false), b1 = __builtin_amdgcn_cvt_pk_f32_fp8((int)R.z[j].x, true);
                yv = (f32x4){a0.x, a0.y, a1.x, a1.y} * R.ga + (f32x4){b0.x, b0.y, b1.x, b1.y} * R.gb; }
            else yv = (f32x4){bf_lo(R.y[j].x), bf_hi(R.y[j].x), bf_lo(R.y[j].y), bf_hi(R.y[j].y)};
            v[j] = xv[j] * ALPHA + V.gg[j] * yv; }
        float mean, rstd; row_stats(v, mean, rstd);
#pragma unroll
        for (int j = 0; j < 4; ++j) v[j] = (v[j] - mean) * rstd * V.lg[j] + V.lb[j];
        if (!ISCTX && !LASTOUT) { unsigned short* xb = valid ? (unsigned short*)(F.ws + WS_XB) + (size_t)r * D : (unsigned short*)DUM;
#pragma unroll
            for (int j = 0; j < 4; ++j) { u32x2 w; w.x = pkh2(v[j][0], v[j][1]); w.y = pkh2(v[j][2], v[j][3]); *(u32x2*)(xb + 4 * F.lane + 256 * j) = w; }
        } else { float* xo = valid ? xrow_out(F, r) : (float*)DUM;
#pragma unroll
            for (int j = 0; j < 4; ++j) *(f32x4*)(xo + 4 * F.lane + 256 * j) = v[j]; }
    }
    if (FEED) { float mean, rstd; row_stats(v, mean, rstd);
        if (MODE == 1 && !ISCTX) { float* st = (valid && F.lane == 0) ? (float*)(F.ws + WS_ROWST) + 2 * (size_t)r : (float*)DUM + 2 * F.lane; *(f32x2*)st = (f32x2){mean, rstd}; }
        bf16_t* orow = valid ? (bf16_t*)(F.ws + WS_HA) + (size_t)r * D : (bf16_t*)DUM; unsigned char* o8 = valid ? F.ws + WS_HA8 + (size_t)r * D : DUM;
#pragma unroll
        for (int j = 0; j < 4; ++j) { const f32x4 hh = (v[j] - mean) * rstd * (V.sc[j] + 1.0f) + V.sh[j]; u32x2 w; w.x = pk2(hh[0], hh[1]); w.y = pk2(hh[2], hh[3]);
            if (HOC) __hip_atomic_store((unsigned long long*)(orow + 4 * F.lane + 256 * j), ((unsigned long long)w.y << 32) | w.x, __ATOMIC_RELAXED, __HIP_MEMORY_SCOPE_AGENT);
            else if (MODE != 1 || ISCTX) *(u32x2*)(orow + 4 * F.lane + 256 * j) = w;
            if (MODE == 1) { int q = __builtin_amdgcn_cvt_pk_fp8_f32(f8clamp(hh[0]), f8clamp(hh[1]), 0, false); q = __builtin_amdgcn_cvt_pk_fp8_f32(f8clamp(hh[2]), f8clamp(hh[3]), q, true); *(unsigned*)(o8 + 4 * F.lane + 256 * j) = (unsigned)q; } } }
    if (HOC) { asm volatile("s_waitcnt vmcnt(0)" ::: "memory"); if (F.lane == 0) __hip_atomic_fetch_add(ctxin + ((r - NLAT) >> 8) * 64, 1u, __ATOMIC_RELAXED, __HIP_MEMORY_SCOPE_AGENT); }
}
template <int MODE, bool FEED> DI void rows_load_vecs(RowVecs& V, const Ctx& F, int l, int b) {
    const float* mod = (const float*)(F.ws + WS_MOD) + (size_t)(MODE == 0 ? 0 : l) * 9 * 6144 + (size_t)b * 6144;
    const float* pg = mod + (MODE == 1 ? 2 * D : 5 * D); const float* psh = (MODE == 0) ? mod : (MODE == 1 ? mod + 3 * D : mod + 9 * 6144); const float* psc = (MODE == 0) ? mod + D : (MODE == 1 ? mod + 4 * D : mod + 9 * 6144 + D);
#pragma unroll
    for (int j = 0; j < 4; ++j) { const int c = 4 * F.lane + 256 * j; if (MODE != 0) V.gg[j] = *(const f32x4*)(pg + c);
        if (FEED) { V.sh[j] = *(const f32x4*)(psh + c); V.sc[j] = *(const f32x4*)(psc + c); } }
}
template <int MODE, bool SRC16, bool FEED, bool LASTOUT> DI void rows_run(const Ctx& F, PP p, int l, const int rbase, const int n, RowVecs& V) {
    rows_load_vecs<MODE, FEED>(V, F, l, rbase >> 13);
#define ROW_C(k) (rbase + 8 * ((k) < n ? (k) : n - 1))
    RowBuf<MODE> r0, r1, r2;
    r0.sv = r1.sv = r2.sv = (u32x2){0u, 0u}; r0.gv = r1.gv = r2.gv = (f32x2){0.f, 0.f};
    rows_slot_load<MODE>(r0.sv, r0.gv, F, ROW_C(0)); rows_slot_load<MODE>(r1.sv, r1.gv, F, ROW_C(1)); rows_slot_load<MODE>(r2.sv, r2.gv, F, ROW_C(2));
    rows_data_load<MODE, SRC16>(r0, F, p, l, ROW_C(0), r0.sv, r0.gv); rows_data_load<MODE, SRC16>(r1, F, p, l, ROW_C(1), r1.sv, r1.gv);
    auto step = [&](RowBuf<MODE>& cur, RowBuf<MODE>& ld, const int k) __attribute__((always_inline)) {
        rows_slot_load<MODE>(cur.sv, cur.gv, F, ROW_C(k + 3));
        rows_data_load<MODE, SRC16>(ld, F, p, l, ROW_C(k + 2), ld.sv, ld.gv);
        row_compute<MODE, SRC16, false, FEED, LASTOUT, false>(F, cur, V, ROW_C(k), k < n, nullptr);
    };
    step(r0, r2, 0); step(r1, r0, 1); step(r2, r1, 2);
    for (int k = 3; k < n; k += 3) { step(r0, r2, k); step(r1, r0, k + 1); step(r2, r1, k + 2); }
#undef ROW_C
}
template <int MODE, bool HANDOFF> DI void phase_rows(const Ctx& F, PP p, int l, int nrows) {
    constexpr bool FEED = (MODE != 2) || HANDOFF, LASTOUT = (MODE == 2) && !HANDOFF;
    const int gw = F.vcu * 8 + F.wave, NGW = F.G * 8;
    constexpr int PU = (MODE == 0) ? 22 : 26, PO = (MODE == 0) ? 35 : 34;
    static_assert(448 * PU + 1600 * PO >= NLAT, "row split");
    const bool ho = HANDOFF && F.G == 256;
    const int per = ho ? (F.vcu < 56 ? PU : PO) : (NLAT + NGW - 1) / NGW;
    const int lstart = (ho ? (F.vcu < 56 ? F.vcu * 8 * PU : 448 * PU + (F.vcu - 56) * 8 * PO) : F.vcu * 8 * per) + F.wave;
    const int nctx = (nrows > NLAT) ? (nrows - NLAT + NGW - 1) / NGW : 0;
    int nlat = (NLAT - lstart + 7) / 8; nlat = nlat < 0 ? 0 : (nlat > per ? per : nlat);
    unsigned* ctxin = (unsigned*)(F.ws + WS_CTL) + CW_CTXIN + (MODE == 0 ? 0 : l + 1) * 8 * 64;
    RowVecs V;
    if (MODE != 0) { const float* g = gin(p, MODE == 1 ? I_LN1G : I_LN2G) + l * D; const float* bb = gin(p, MODE == 1 ? I_LN1B : I_LN2B) + l * D;
#pragma unroll
        for (int j = 0; j < 4; ++j) { V.lg[j] = *(const f32x4*)(g + 4 * F.lane + 256 * j); V.lb[j] = *(const f32x4*)(bb + 4 * F.lane + 256 * j); } }
    auto ctx_rows = [&]() __attribute__((always_inline)) {
        for (int k = 0; k < nctx; ++k) { const int r = NLAT + gw + k * NGW; if (r >= nrows) break;
            rows_load_vecs<MODE, FEED>(V, F, l, 8);
            RowBuf<MODE> rb; u32x2 sv = (u32x2){0u, 0u}; f32x2 gv = (f32x2){0.f, 0.f}; rows_slot_load<MODE>(sv, gv, F, r); rows_data_load<MODE, false>(rb, F, p, l, r, sv, gv);
            if (ho) row_compute<MODE, false, true, FEED, LASTOUT, HANDOFF>(F, rb, V, r, true, ctxin); else row_compute<MODE, false, true, FEED, LASTOUT, false>(F, rb, V, r, true, ctxin); } };
    if (ho) ctx_rows();
    for (int k0 = 0; k0 < nlat; ) {
        const int rbase = lstart + 8 * k0; const int rend = ((rbase >> 13) + 1) << 13; int n = (rend - rbase + 7) / 8; n = n < nlat - k0 ? n : nlat - k0;
        if (MODE == 2) rows_run<MODE, true, FEED, LASTOUT>(F, p, l, rbase, n, V);
        else if (MODE == 1 && l > 0) rows_run<MODE, MODE == 1, FEED, LASTOUT>(F, p, l, rbase, n, V);
        else rows_run<MODE, false, FEED, LASTOUT>(F, p, l, rbase, n, V);
        k0 += n; }
    if (!ho) ctx_rows();
    if (ho && nctx > 0 && F.vcu < 56) {
        const int tile = F.vcu / 7, pn = F.vcu % 7, ln = (MODE == 0) ? 0 : l + 1;
        __syncthreads();
        if (F.wave == 0) { unsigned* cw = ctxin + tile * 64; unsigned spins = 0;
            while ((unsigned)__builtin_amdgcn_readfirstlane(__hip_atomic_load(cw, __ATOMIC_RELAXED, __HIP_MEMORY_SCOPE_AGENT)) < 256u) { __builtin_amdgcn_s_sleep(4); if (++spins > (1u << 22)) break; }
            __builtin_amdgcn_fence(__ATOMIC_ACQUIRE, "agent"); asm volatile("s_waitcnt vmcnt(0)" ::: "memory"); }
        __syncthreads();
        pg8::OneUnit S; S.pm = NLAT / 256 + tile; S.pn = pn; S.K = 1024;
        pg8::EpiInproj E{(bf16_t*)(F.ws + WS_U), (bf16_t*)(F.ws + WS_G), (bf16_t*)(F.ws + WS_Q), (bf16_t*)(F.ws + WS_KB), (bf16_t*)(F.ws + WS_VT), (bf16_t*)(F.ws + WS_VTC), (const LAS float*)(F.lds + ROPE_OFF)};
        pg8::gemm_phase<pg8::EpiInproj, pg8::OneUnit>(F.lds, F.tid, (const bf16_t*)(F.ws + WS_HA), (const bf16_t*)(F.ws + WS_WIN) + (size_t)ln * DIN * 1024, 1024, S, E);
    }
}
DI void phase_scan(const Ctx& F, PP p, int l) {
    constexpr int XC_OFF = 0, AGG_OFF = 36864, CARRY_OFF = 36864 + 8192;
    const bf16_t* U = (const bf16_t*)(F.ws + WS_U); bf16_t* XV = (bf16_t*)(F.ws + WS_XCV);
    unsigned* cnt = (unsigned*)(F.ws + WS_CTL) + CW_SCANX + l * 64 * 64;
    for (int it = F.vcu; it < 256; it += F.G) {
        const int b = it >> 5, cb = (it >> 2) & 7, qd = it & 3;
        const int ck = F.lane & 7, rsub = F.lane >> 3;
        float w[4][8], bias[8];
#pragma unroll
        for (int j = 0; j < 4; ++j) { const f32x4 wa = *(const f32x4*)(gin(p, I_CONVW) + (l * 4 + j) * DR + cb * 64 + ck * 8), wb = *(const f32x4*)(gin(p, I_CONVW) + (l * 4 + j) * DR + cb * 64 + ck * 8 + 4);
            w[j][0] = wa[0]; w[j][1] = wa[1]; w[j][2] = wa[2]; w[j][3] = wa[3]; w[j][4] = wb[0]; w[j][5] = wb[1]; w[j][6] = wb[2]; w[j][7] = wb[3]; }
        { const f32x4 ba = *(const f32x4*)(gin(p, I_CONVB) + l * DR + cb * 64 + ck * 8), bb = *(const f32x4*)(gin(p, I_CONVB) + l * DR + cb * 64 + ck * 8 + 4);
          bias[0] = ba[0]; bias[1] = ba[1]; bias[2] = ba[2]; bias[3] = ba[3]; bias[4] = bb[0]; bias[5] = bb[1]; bias[6] = bb[2]; bias[7] = bb[3]; }
#define CONV_GEOM(blk_) const int idx0 = 2112 * qd + 32 * (blk_) + 4 * rsub; const bool isctx = idx0 < CL; const int L = isctx ? CL : SEQ; const int pos0 = isctx ? idx0 : idx0 - CL; const int rowbase = isctx ? NLAT + b * CL : b * SEQ;
#define CONV_LOAD(dst, blk_) do { CONV_GEOM(blk_); _Pragma("unroll") for (int k = 0; k < 7; ++k) { int pos = pos0 - 2 + k; const bool ok = pos >= 0 && pos < L; pos = ok ? pos : pos0; \
            const u32x4 t = *(const u32x4*)(U + (size_t)(rowbase + pos) * DR + cb * 64 + ck * 8); dst[k] = ok ? t : (u32x4){0u, 0u, 0u, 0u}; } } while (0)
#define CONV_DO(src, blk_) do { CONV_GEOM(blk_); _Pragma("unroll") for (int i = 0; i < 4; ++i) { float x[8]; \
            _Pragma("unroll") for (int e = 0; e < 8; ++e) x[e] = bias[e]; \
            _Pragma("unroll") for (int j = 0; j < 4; ++j) _Pragma("unroll") for (int e = 0; e < 4; ++e) { x[2 * e] = __builtin_fmaf(w[j][2 * e], bf_lo(src[i + j][e]), x[2 * e]); x[2 * e + 1] = __builtin_fmaf(w[j][2 * e + 1], bf_hi(src[i + j][e]), x[2 * e + 1]); } \
            u32x4 o; o.x = pk2(x[0], x[1]); o.y = pk2(x[2], x[3]); o.z = pk2(x[4], x[5]); o.w = pk2(x[6], x[7]); \
            *(u32x4*)(XV + (size_t)(rowbase + pos0 + i) * DR + cb * 64 + ck * 8) = o; } } while (0)
        u32x4 ua[7], ub[7];
        CONV_LOAD(ua, F.wave);
        for (int blk = F.wave; blk < 66; blk += 16) {
            { const int bn = blk + 8 < 66 ? blk + 8 : blk; CONV_LOAD(ub, bn); }
            CONV_DO(ua, blk);
            { const int bn = blk + 16 < 66 ? blk + 16 : blk; CONV_LOAD(ua, bn); }
            if (blk + 8 < 66) CONV_DO(ub, blk + 8);
        }
#undef CONV_DO
#undef CONV_GEOM
#undef CONV_LOAD
    }
    asm volatile("s_waitcnt vmcnt(0)" ::: "memory"); __syncthreads();
    if (F.tid == 0) { __builtin_amdgcn_fence(__ATOMIC_RELEASE, "agent");
        for (int it = F.vcu; it < 256; it += F.G) __hip_atomic_fetch_add(cnt + (it >> 2) * 64, 1u, __ATOMIC_RELAXED, __HIP_MEMORY_SCOPE_AGENT); }
    const int c = F.lane & 31, h = F.lane >> 5, hw = 2 * F.wave + h;
    for (int it = F.vcu; it < 256; it += F.G) {
        const int b = it >> 5, cb = (it >> 2) & 7, dir = (it >> 1) & 1, half = it & 1;
        const int oc = cb * 64 + 32 * half + c;
        bf16_t* OUT = (bf16_t*)(F.ws + (dir ? WS_HB : WS_HF));
        if (F.wave == 0) { unsigned* cw = cnt + (it >> 2) * 64; unsigned spins = 0;
            while ((unsigned)__builtin_amdgcn_readfirstlane(__hip_atomic_load(cw, __ATOMIC_RELAXED, __HIP_MEMORY_SCOPE_AGENT)) < 4u) { __builtin_amdgcn_s_sleep(2); if (++spins > (1u << 22)) break; }
            __builtin_amdgcn_fence(__ATOMIC_ACQUIRE, "agent"); }
        __syncthreads();
        bf16x8 Bwa[4], Bwx[4];
        { const float* wa = gin(p, I_RGWA) + ((size_t)((l * 2 + dir) * 8 + cb) * 64) * 64 + 32 * half + c;
          const float* wx = gin(p, I_RGWX) + ((size_t)((l * 2 + dir) * 8 + cb) * 64) * 64 + 32 * half + c;
#pragma unroll
          for (int s = 0; s < 4; ++s) { u32x4 a, x;
#pragma unroll
              for (int j = 0; j < 4; ++j) { const int i0 = 16 * s + 8 * h + 2 * j; a[j] = pk2(-LOG2E * wa[(size_t)i0 * 64], -LOG2E * wa[(size_t)(i0 + 1) * 64]); x[j] = pk2(-LOG2E * wx[(size_t)i0 * 64], -LOG2E * wx[(size_t)(i0 + 1) * 64]); }
              Bwa[s] = __builtin_bit_cast(bf16x8, a); Bwx[s] = __builtin_bit_cast(bf16x8, x); } }
        const float ba = -LOG2E * gin(p, I_RGBA)[(l * 2 + dir) * DR + oc], bx = -LOG2E * gin(p, I_RGBX)[(l * 2 + dir) * DR + oc];
        float c8;
        { const float lam = gin(p, I_RGLAM)[(l * 2 + dir) * DR + oc]; const float e = __expf(-lam);
          const float sp = (e < 0.03f) ? e * (1.0f - e * (0.5f - e * (0.33333333f - 0.25f * e))) : __logf(1.0f + e); c8 = -8.0f * sp; }
        const float c8l = c8 * LOG2E;
        LAS unsigned char* XCw = F.lds + XC_OFF + F.wave * 4608;
        LAS float* CARRY = (LAS float*)(F.lds + CARRY_OFF);
        const int tokr = 16 * ((c >> 2) & 1) + (c & 3) + 4 * (c >> 3);
        u32x4 pre[4];
#define SCAN_GEOM(sc_) const bool isctx_ = ((sc_) == 0); const int L_ = isctx_ ? CL : SEQ; const int tau0_ = isctx_ ? 0 : 256 * ((sc_) - 1); \
        const int plo_ = dir ? L_ - tau0_ - 256 : tau0_; const int rowbase_ = isctx_ ? NLAT + b * CL : b * SEQ;
#define SCAN_LOAD(sc_) do { SCAN_GEOM(sc_); _Pragma("unroll") for (int k = 0; k < 4; ++k) { const int q = F.lane + 64 * k, j = q >> 3, ck = q & 7; const int st = 32 * F.wave + j; \
            const int pos = dir ? plo_ + 255 - st : plo_ + st; pre[k] = *(const u32x4*)(XV + (size_t)(rowbase_ + pos) * DR + cb * 64 + ck * 8); } } while (0)
        SCAN_LOAD(0);
        for (int sc = 0; sc < 33; ++sc) {
            SCAN_GEOM(sc); const int p_lo = plo_, rowbase = rowbase_;
            LAS f32x2* AGG = (LAS f32x2*)(F.lds + AGG_OFF + (sc & 1) * 4096);
#pragma unroll
            for (int k = 0; k < 4; ++k) { const int q = F.lane + 64 * k; *(LAS u32x4*)(XCw + (q >> 3) * 144 + (q & 7) * 16) = pre[k]; }
            if (sc + 1 < 33) SCAN_LOAD(sc + 1);
            asm volatile("s_waitcnt lgkmcnt(0)" ::: "memory");
            float xo[16];
#pragma unroll
            for (int i = 0; i < 16; ++i) xo[i] = bf2f(*(const LAS bf16_t*)(XCw + (16 * h + i) * 144 + 2 * (32 * half + c)));
            f32x16 Da, Dx;
#pragma unroll
            for (int i = 0; i < 16; ++i) { Da[i] = ba; Dx[i] = bx; }
#pragma unroll
            for (int s = 0; s < 4; ++s) { const bf16x8 Af = *(const LAS bf16x8*)(XCw + tokr * 144 + 32 * s + 16 * h);
                Da = __builtin_amdgcn_mfma_f32_32x32x16_bf16(Af, Bwa[s], Da, 0, 0, 0); Dx = __builtin_amdgcn_mfma_f32_32x32x16_bf16(Af, Bwx[s], Dx, 0, 0, 0); }
            float H[16], PP[16]; float hloc = 0.f, P = 1.f;
#pragma unroll
            for (int i = 0; i < 16; ++i) {
                const float r = fast_rcp(1.0f + fast_exp2(Da[i])), gi = fast_rcp(1.0f + fast_exp2(Dx[i]));
                const float a = fast_exp2(c8l * r);
                const float om = __builtin_fmaf(-a, a, 1.0f);
                const float bb = __builtin_amdgcn_sqrtf(om) * gi * xo[i];
                hloc = __builtin_fmaf(a, hloc, bb); P *= a; H[i] = hloc; PP[i] = P; }
            AGG[hw * 32 + c] = (f32x2){P, hloc};
            lds_barrier();
            float cin = CARRY[(sc & 1) * 32 + c]; f32x2 agv[15];
#pragma unroll
            for (int k = 0; k < 15; ++k) agv[k] = AGG[k * 32 + c];
            __builtin_amdgcn_sched_barrier(0);
            cin = (sc == 0) ? 0.f : cin;
#pragma unroll
            for (int k = 0; k < 15; ++k) { const float nc = agv[k].x * cin + agv[k].y; cin = (k < hw) ? nc : cin; }
            if (hw == 15) CARRY[((sc + 1) & 1) * 32 + c] = P * cin + hloc;
#pragma unroll
            for (int i = 0; i < 16; i += 2) { const float hv0 = __builtin_fmaf(PP[i], cin, H[i]), hv1 = __builtin_fmaf(PP[i + 1], cin, H[i + 1]);
                const unsigned pk = dir ? pk2(hv1, hv0) : pk2(hv0, hv1);
                const int pe = dir ? p_lo + 254 - (16 * hw + i) : p_lo + 16 * hw + i;
                unsigned* ob = (unsigned*)OUT + ((size_t)(cb * 2 + half) * (NT / 2) + (size_t)(rowbase >> 1)) * 32;
                ob[(unsigned)((pe >> 1) * 32 + c)] = pk; }
        }
#undef SCAN_GEOM
#undef SCAN_LOAD
        __syncthreads();
    }
}

DI int crow16(int i, int h) { return (i & 3) + 8 * (i >> 2) + 4 * h; }
DI bf16x8 pack8(const f32x16& x, int s) { u32x4 q; q.x = pk2(x[8 * s], x[8 * s + 1]); q.y = pk2(x[8 * s + 2], x[8 * s + 3]); q.z = pk2(x[8 * s + 4], x[8 * s + 5]); q.w = pk2(x[8 * s + 6], x[8 * s + 7]); return __builtin_bit_cast(bf16x8, q); }
#define ATT_DEAD(qb, kb) ((MM == 1 && (qb) == 1 && (kb) == 0) || (MM == 2 && (qb) == 0 && (kb) == 1))
constexpr float ATT_THR = 6.0f;
template <int MM, int QB> DI void att_st(f32x16 (&St)[2], const LAS unsigned char* Kl, const bf16x8 (&Qf)[2][4], const float (&mrun)[2], const int c, const int h) {
    const float m0 = -mrun[QB];
#pragma unroll
    for (int kb = 0; kb < 2; ++kb)
#pragma unroll
        for (int i = 0; i < 16; ++i) St[kb][i] = m0;
    constexpr int NKB = (ATT_DEAD(QB, 0) ? 0 : 1) + (ATT_DEAD(QB, 1) ? 0 : 1), KB0 = ATT_DEAD(QB, 0) ? 1 : 0, NF = 4 * NKB;
#define ATT_KF(i_) (*(const LAS bf16x8*)(Kl + (32 * (NKB == 2 ? ((i_) & 1) : KB0) + c) * 144 + 32 * (NKB == 2 ? ((i_) >> 1) : (i_)) + 16 * h))
    bf16x8 Kw[3]; Kw[0] = ATT_KF(0); Kw[1] = ATT_KF(1);
#pragma unroll
    for (int i = 0; i < NF; ++i) { const int kb = (NKB == 2) ? (i & 1) : KB0, s = (NKB == 2) ? (i >> 1) : i;
        if (i + 2 < NF) Kw[(i + 2) % 3] = ATT_KF(i + 2);
        St[kb] = __builtin_amdgcn_mfma_f32_32x32x16_bf16(Kw[i % 3], Qf[QB][s], St[kb], 0, 0, 0); }
    if (QB == 0 && NF >= 2) {
        __builtin_amdgcn_sched_group_barrier(0x100, 2, 0);
#pragma unroll
        for (int i = 0; i < NF - 2; ++i) { __builtin_amdgcn_sched_group_barrier(0x008, 1, 0); __builtin_amdgcn_sched_group_barrier(0x100, 1, 0); }
        __builtin_amdgcn_sched_group_barrier(0x008, 2, 0); }
#undef ATT_KF
}
template <int MM, int QB> DI void att_softmax(f32x16 (&St)[2], bf16x8 (&Pf)[2][2], f32x16 (&O)[2][2], float (&mrun)[2], float (&lsum)[2], const int c, const int h) {
    if (MM != 0) {
#pragma unroll
        for (int kb = 0; kb < 2; ++kb) {
            if (ATT_DEAD(QB, kb)) {
#pragma unroll
                for (int i = 0; i < 16; ++i) St[kb][i] = -1.0e30f;
            } else if (kb == QB) {
#pragma unroll
                for (int i = 0; i < 16; ++i) { const int kr = crow16(i, h); const bool bad = (MM == 1) ? (c > kr) : (kr > c); St[kb][i] = bad ? -1.0e30f : St[kb][i]; }
            } }
    }
    float tmax = -3.0e38f;
#pragma unroll
    for (int kb = 0; kb < 2; ++kb)
#pragma unroll
        for (int i = 0; i < 16; ++i) tmax = fmaxf(tmax, St[kb][i]);
    tmax = xor32_max(tmax);
    if (__builtin_amdgcn_ballot_w64(tmax > ATT_THR) != 0ull) {
        const float d = fmaxf(tmax, 0.f); const float alpha = fast_exp2(-d); mrun[QB] += d; lsum[QB] *= alpha;
#pragma unroll
        for (int kb = 0; kb < 2; ++kb)
#pragma unroll
            for (int i = 0; i < 16; ++i) St[kb][i] -= d;
#pragma unroll
        for (int db = 0; db < 2; ++db)
#pragma unroll
            for (int i = 0; i < 16; ++i) O[db][QB][i] *= alpha;
    }
    float ps = 0.f;
#pragma unroll
    for (int kb = 0; kb < 2; ++kb) {
#pragma unroll
        for (int i = 0; i < 16; ++i) { const float pv = fast_exp2(St[kb][i]); St[kb][i] = pv; ps += pv; }
        Pf[kb][0] = pack8(St[kb], 0); Pf[kb][1] = pack8(St[kb], 1); }
    lsum[QB] += ps;
}
template <int MM, int QB> DI void att_pv(const bf16x8 (&Pf)[2][2], f32x16 (&O)[2][2], const LAS unsigned char* Vl, const int c, const int h) {
    constexpr int NKB = (ATT_DEAD(QB, 0) ? 0 : 1) + (ATT_DEAD(QB, 1) ? 0 : 1), KB0 = ATT_DEAD(QB, 0) ? 1 : 0, NF = 4 * NKB;
#define ATT_VF(i_) (*(const LAS bf16x8*)(Vl + (32 * ((i_) & 1) + c) * 144 + (32 * (NKB == 2 ? ((i_) >> 2) : KB0) + 16 * (((i_) >> 1) & 1) + 8 * h) * 2))
    bf16x8 Vw[3]; Vw[0] = ATT_VF(0); Vw[1] = ATT_VF(1);
#pragma unroll
    for (int i = 0; i < NF; ++i) { const int db = i & 1, s2 = (i >> 1) & 1, kb = (NKB == 2) ? (i >> 2) : KB0;
        if (i + 2 < NF) Vw[(i + 2) % 3] = ATT_VF(i + 2);
        O[db][QB] = __builtin_amdgcn_mfma_f32_32x32x16_bf16(Vw[i % 3], Pf[kb][s2], O[db][QB], 0, 0, 0); }
    if (QB == 1 && NF >= 2) {
        __builtin_amdgcn_sched_group_barrier(0x100, 2, 0);
#pragma unroll
        for (int i = 0; i < NF - 2; ++i) { __builtin_amdgcn_sched_group_barrier(0x008, 1, 0); __builtin_amdgcn_sched_group_barrier(0x100, 1, 0); }
        __builtin_amdgcn_sched_group_barrier(0x008, 2, 0); }
#undef ATT_VF
}
template <int MM> DI void att_tile(const LAS unsigned char* Kl, const LAS unsigned char* Vl, const bf16x8 (&Qf)[2][4], f32x16 (&O)[2][2], float (&mrun)[2], float (&lsum)[2], const int c, const int h) {
    f32x16 St0[2], St1[2]; bf16x8 Pf0[2][2], Pf1[2][2];
    __builtin_amdgcn_sched_barrier(0);
    att_st<MM, 0>(St0, Kl, Qf, mrun, c, h);
    __builtin_amdgcn_sched_barrier(0);
    att_st<MM, 1>(St1, Kl, Qf, mrun, c, h);
    att_softmax<MM, 0>(St0, Pf0, O, mrun, lsum, c, h);
    __builtin_amdgcn_sched_barrier(0);
    att_pv<MM, 0>(Pf0, O, Vl, c, h);
    att_softmax<MM, 1>(St1, Pf1, O, mrun, lsum, c, h);
    __builtin_amdgcn_sched_barrier(0);
    att_pv<MM, 1>(Pf1, O, Vl, c, h);
    __builtin_amdgcn_sched_barrier(0);
}
#undef ATT_DEAD
DI void phase_attn(const Ctx& F, PP p, int l) {
    constexpr int STG = 36864, V_OFF = 18432, SS_OFF = 3 * 36864;
    const bf16_t* Q = (const bf16_t*)(F.ws + WS_Q); const bf16_t* Kb = (const bf16_t*)(F.ws + WS_KB); const bf16_t* Vt = (const bf16_t*)(F.ws + WS_VT); const bf16_t* Vtc = (const bf16_t*)(F.ws + WS_VTC);
    const bf16_t* HF = (const bf16_t*)(F.ws + WS_HF); const bf16_t* HB = (const bf16_t*)(F.ws + WS_HB); const bf16_t* Gt = (const bf16_t*)(F.ws + WS_G); bf16_t* HA = (bf16_t*)(F.ws + WS_HA);
    const int nitems = 1024 + ((l < DEPTH - 1) ? 32 : 0);
    const int head = F.wave, kvh = F.wave >> 2;
    const float* gna = gin(p, I_GNA) + l * 512 + head * 64; const float* gnr = gin(p, I_GNR) + l * 512;
    LAS float* SS = (LAS float*)(F.lds + SS_OFF);
    unsigned* ctxcnt = (unsigned*)(F.ws + WS_CTL) + CW_CTXMIX + l * 8 * 64;
    const bool hasctx = nitems > 1024;
    for (int k2 = 0; k2 < 10; ++k2) {
        const bool do_attn = (((k2 ^ F.vcu) & 1) == 0);
        int it;
        if ((k2 >> 1) == 0) { const int v = F.vcu; if (!hasctx) continue; if (do_attn) { if (v >= 32) continue; it = 1024 + v; } else { if (v < 32 || v >= 64) continue; it = 1024 + (v - 32); } }
        else { it = F.vcu + ((k2 >> 1) - 1) * F.G; if (it >= 1024) continue; }
      if (do_attn) {
        const int ti = F.wave * 64 + lane_id_v();
        const int lane_i = ti & 63, c = ti & 31, h = (ti >> 5) & 1;
        const bool islat = it < 1024; int b, q0 = 0, rowbase, kk_lo = 0, nb = 0;
        if (islat) { b = it >> 7; q0 = (it & 127) * 64; rowbase = b * SEQ + q0; kk_lo = -(q0 >> 6); if (kk_lo < -2) kk_lo = -2; int kk_hi = (SEQ - 64 - q0) >> 6; if (kk_hi > 2) kk_hi = 2; nb = kk_hi - kk_lo + 1; }
        else { const int ci = it - 1024; b = ci >> 2; rowbase = NLAT + b * CL + (ci & 3) * 64; }
        const int ntile = nb + 4;
        bf16x8 Qf[2][4];
#pragma unroll
        for (int qb = 0; qb < 2; ++qb)
#pragma unroll
            for (int s = 0; s < 4; ++s) Qf[qb][s] = *(const bf16x8*)(Q + (size_t)(rowbase + 32 * qb + c) * 512 + head * 64 + 16 * s + 8 * h);
        const float sink2 = gin(p, I_SINK)[l * 8 + head] * LOG2E;
        float mrun[2] = {sink2, sink2}, lsum[2]; lsum[0] = lsum[1] = (h == 0) ? 1.0f : 0.0f;
        asm volatile("" ::: "memory");
        f32x16 O[2][2];
#pragma unroll
        for (int db = 0; db < 2; ++db)
#pragma unroll
            for (int qb = 0; qb < 2; ++qb)
#pragma unroll
                for (int i = 0; i < 16; ++i) O[db][qb][i] = 0.f;
#define ATT_SRC(j, krow0, vbase, ldv, mode) int krow0; const bf16_t* vbase; int ldv; int mode = 0; \
        if ((j) < nb) { const int kk = kk_lo + (j); const int k0 = q0 + 64 * kk; krow0 = b * SEQ + k0; vbase = Vt + (size_t)(b * 128) * SEQ + k0; ldv = SEQ; mode = (kk == -2) ? 1 : ((kk == 2) ? 2 : 0); } \
        else { const int cx = (j) - nb; krow0 = NLAT + b * CL + 64 * cx; vbase = Vtc + (size_t)(b * 128) * CL + 64 * cx; ldv = CL; }
#define ATT_DMA(buf, krow0, vbase, ldv) do { int ln_ = lane_i; asm volatile("" : "+v"(ln_)); _Pragma("unroll") for (int t_ = 0; t_ < 5; ++t_) { const int in_ = F.wave + 8 * t_; if (in_ < 36) { const bf16_t* g_; \
            if (in_ < 18) { const int q_ = in_ * 64 + ln_; const int kvh_ = q_ / 576, rem_ = q_ - kvh_ * 576, key_ = rem_ / 9, col_ = rem_ - key_ * 9; g_ = Kb + (size_t)((krow0) + key_) * 128 + kvh_ * 64 + (col_ & 7) * 8; } \
            else { const int q_ = (in_ - 18) * 64 + ln_; const int row_ = q_ / 9, col_ = q_ - row_ * 9; g_ = (vbase) + (size_t)row_ * (ldv) + (col_ & 7) * 8; } \
            __builtin_amdgcn_global_load_lds((const unsigned*)g_, (LAS unsigned*)(F.lds + (buf) * STG + in_ * 1024), 16, 0, 0); } } } while (0)
#define ATT_WAITN(has) do { if (has) { if (F.wave < 4) asm volatile("s_waitcnt vmcnt(5)" ::: "memory"); else asm volatile("s_waitcnt vmcnt(4)" ::: "memory"); } else asm volatile("s_waitcnt vmcnt(0)" ::: "memory"); } while (0)
        { ATT_SRC(0, krow0, vbase, ldv, mode0); (void)mode0; ATT_DMA(0, krow0, vbase, ldv); }
        if (ntile > 1) { ATT_SRC(1, krow1, vbase1, ldv1, mode1); (void)mode1; ATT_DMA(1, krow1, vbase1, ldv1); }
        ATT_WAITN(ntile > 1); lds_barrier();
        for (int j = 0; j < ntile; ++j) {
            asm volatile("; ATT_TILE_BEGIN");
            ATT_SRC(j, krow_c, vbase_c, ldv_c, mode); (void)krow_c; (void)vbase_c; (void)ldv_c;
            const int jb = j % 3;
            if (j + 2 < ntile) { ATT_SRC(j + 2, krow_n, vbase_n, ldv_n, mode_n); (void)mode_n; const int nbuf = (j + 2) % 3; ATT_DMA(nbuf, krow_n, vbase_n, ldv_n); }
            const LAS unsigned char* Kl = F.lds + jb * STG + kvh * 64 * 144;
            const LAS unsigned char* Vl = F.lds + jb * STG + V_OFF + kvh * 64 * 144;
            if (mode == 0) att_tile<0>(Kl, Vl, Qf, O, mrun, lsum, c, h); else if (mode == 1) att_tile<1>(Kl, Vl, Qf, O, mrun, lsum, c, h); else att_tile<2>(Kl, Vl, Qf, O, mrun, lsum, c, h);
            asm volatile("; ATT_TILE_END");
            ATT_WAITN(j + 2 < ntile); lds_barrier();
        }
        asm volatile("; ATT_EPI"); const int tz = F.wave * 64 + lane_id_v();
        const int c2 = tz & 31, h2 = (tz >> 5) & 1, lane2 = tz & 63, wave2 = __builtin_amdgcn_readfirstlane(tz >> 6);
#undef ATT_SRC
#undef ATT_DMA
#undef ATT_WAITN
        const float* gna2 = gin(p, I_GNA) + l * 512 + wave2 * 64;
        float ssq[2];
#pragma unroll
        for (int qb = 0; qb < 2; ++qb) { const float lt = xor32_sum(lsum[qb]); const float inv = 1.0f / lt; float s = 0.f;
#pragma unroll
            for (int db = 0; db < 2; ++db)
#pragma unroll
                for (int i = 0; i < 16; ++i) { O[db][qb][i] *= inv; s += O[db][qb][i] * O[db][qb][i]; }
            s = xor32_sum(s); ssq[qb] = s; if (h2 == 0) SS[wave2 * 64 + 32 * qb + c2] = s; }
        __syncthreads();
#pragma unroll
        for (int qb = 0; qb < 2; ++qb) { float tot = 0.f;
#pragma unroll
            for (int w = 0; w < 8; ++w) tot += SS[w * 64 + 32 * qb + c2];
            const float rstd = 1.0f / sqrtf(tot * (1.0f / 512.0f) + LN_EPS);
            bf16_t* orow = HA + (size_t)(rowbase + 32 * qb + c2) * D + 512 + wave2 * 64;
#pragma unroll
            for (int db = 0; db < 2; ++db) { u32x2 w[4];
#pragma unroll
                for (int g = 0; g < 4; ++g) { const int d0 = 32 * db + 8 * g + 4 * h2; const f32x4 gv = *(const f32x4*)(gna2 + d0);
                    w[g].x = pk2(O[db][qb][4 * g] * rstd * gv[0], O[db][qb][4 * g + 1] * rstd * gv[1]); w[g].y = pk2(O[db][qb][4 * g + 2] * rstd * gv[2], O[db][qb][4 * g + 3] * rstd * gv[3]); }
                if (islat) {
#pragma unroll
                    for (int q = 0; q < 2; ++q) { asm("s_nop 1\n\tv_permlane32_swap_b32 %0, %1" : "+v"(w[q].x), "+v"(w[q + 2].x)); asm("s_nop 1\n\tv_permlane32_swap_b32 %0, %1" : "+v"(w[q].y), "+v"(w[q + 2].y)); }
                    bf16_t* dst = orow + 32 * db + 16 * h2;
                    *(u32x4*)dst = (u32x4){w[0].x, w[0].y, w[2].x, w[2].y}; *(u32x4*)(dst + 8) = (u32x4){w[1].x, w[1].y, w[3].x, w[3].y};
                } else {
#pragma unroll
                    for (int g = 0; g < 4; ++g) { const int d0 = 32 * db + 8 * g + 4 * h2;
                        __hip_atomic_store((unsigned long long*)(orow + d0), ((unsigned long long)w[g].y << 32) | w[g].x, __ATOMIC_RELAXED, __HIP_MEMORY_SCOPE_AGENT); } } } }
        if (!islat) { asm volatile("s_waitcnt vmcnt(0)" ::: "memory"); __syncthreads(); if (F.tid == 0) __hip_atomic_fetch_add(ctxcnt + ((it - 1024) >> 2) * 64, 1u, __ATOMIC_RELAXED, __HIP_MEMORY_SCOPE_AGENT); }
      } else {
        int rowbase; if (it < 1024) rowbase = (it >> 7) * SEQ + (it & 127) * 64; else { const int ci = it - 1024; rowbase = NLAT + (ci >> 2) * CL + (ci & 3) * 64; }
        const int tz3 = F.wave * 64 + lane_id_v(); const int lane2 = tz3 & 63, wave2 = __builtin_amdgcn_readfirstlane(tz3 >> 6);
        { u32x4 ha[4][2], hb[4][2], hg[8];
          const int gq = lane2 >> 2, cc0 = 8 * (lane2 & 3);
#pragma unroll
          for (int j = 0; j < 4; ++j) { const size_t rp = (size_t)((rowbase + 8 * wave2) >> 1) + j; const size_t eo = (((size_t)gq * (NT / 2) + rp) * 32 + cc0) * 2;
              ha[j][0] = *(const u32x4*)(HF + eo); ha[j][1] = *(const u32x4*)(HF + eo + 8); hb[j][0] = *(const u32x4*)(HB + eo); hb[j][1] = *(const u32x4*)(HB + eo + 8); }
#pragma unroll
          for (int t = 0; t < 8; ++t) { const size_t row = (size_t)(rowbase + 8 * wave2 + t); hg[t] = *(const u32x4*)(Gt + row * DR + 8 * lane2); }
          const f32x4 g0 = *(const f32x4*)(gnr + 8 * lane2), g1 = *(const f32x4*)(gnr + 8 * lane2 + 4);
#pragma unroll
          for (int t = 0; t < 8; ++t) { const size_t row = (size_t)(rowbase + 8 * wave2 + t);
              float mv[8]; float s = 0.f;
#pragma unroll
              for (int k = 0; k < 8; ++k) { const unsigned wa = ha[t >> 1][k >> 2][k & 3], wb = hb[t >> 1][k >> 2][k & 3], wg = hg[t][k >> 1];
                  const float hsum = (t & 1) ? bf_hi(wa) + bf_hi(wb) : bf_lo(wa) + bf_lo(wb); const float gk = (k & 1) ? bf_hi(wg) : bf_lo(wg);
                  mv[k] = hsum * gelu_tanh(gk); s += mv[k] * mv[k]; }
              s = wave_sum(s); const float rstd = 1.0f / sqrtf(s * (1.0f / 512.0f) + LN_EPS);
              u32x4 o; o.x = pk2(mv[0] * rstd * g0[0], mv[1] * rstd * g0[1]); o.y = pk2(mv[2] * rstd * g0[2], mv[3] * rstd * g0[3]); o.z = pk2(mv[4] * rstd * g1[0], mv[5] * rstd * g1[1]); o.w = pk2(mv[6] * rstd * g1[2], mv[7] * rstd * g1[3]);
              if (it < 1024) *(u32x4*)(HA + row * D + 8 * lane2) = o;
              else { unsigned long long* d8 = (unsigned long long*)(HA + row * D + 8 * lane2); __hip_atomic_store(d8, ((unsigned long long)o.y << 32) | o.x, __ATOMIC_RELAXED, __HIP_MEMORY_SCOPE_AGENT); __hip_atomic_store(d8 + 1, ((unsigned long long)o.w << 32) | o.z, __ATOMIC_RELAXED, __HIP_MEMORY_SCOPE_AGENT); } } }
        if (it >= 1024) { asm volatile("s_waitcnt vmcnt(0)" ::: "memory"); __syncthreads(); if (F.tid == 0) __hip_atomic_fetch_add(ctxcnt + ((it - 1024) >> 2) * 64, 1u, __ATOMIC_RELAXED, __HIP_MEMORY_SCOPE_AGENT); }
      }
    }
    if (hasctx && F.G == 256 && F.vcu >= 64 && F.vcu < 96) {
        const int j = F.vcu - 64, tile = j >> 2;
        __syncthreads();
        if (F.wave == 0) { unsigned* cw = ctxcnt + tile * 64; unsigned spins = 0;
            while ((unsigned)__builtin_amdgcn_readfirstlane(__hip_atomic_load(cw, __ATOMIC_RELAXED, __HIP_MEMORY_SCOPE_AGENT)) < 8u) { __builtin_amdgcn_s_sleep(4); if (++spins > (1u << 22)) break; }
            __builtin_amdgcn_fence(__ATOMIC_ACQUIRE, "agent"); asm volatile("s_waitcnt vmcnt(0)" ::: "memory"); }
        __syncthreads();
        pg8::OneUnit S; S.pm = NLAT / 256 + tile; S.pn = j & 3; S.K = 1024;
        pg8::EpiPlainBf16 E{(bf16_t*)(F.ws + WS_Y), D, 1.0f};
        pg8::gemm_phase<pg8::EpiPlainBf16, pg8::OneUnit>(F.lds, F.tid, (const bf16_t*)(F.ws + WS_HA), (const bf16_t*)(F.ws + WS_WOUT) + (size_t)l * 1024 * 1024, 1024, S, E);
    }
    if (F.G == 256 && hasctx && F.vcu >= 96) bg_moe_weights(F, p, l + 1, 8);
}

DI void route_block(const Ctx& F, PP p, int l, int row0, int crow0) {
    LAS int* lcnt = (LAS int*)F.lds; LAS int* lbase = lcnt + 32;
    const float* LOG = (const float*)(F.ws + WS_LOG); int* TE = (int*)(F.ws + WS_TOKE); int* TR = (int*)(F.ws + WS_TOKR); float* TG = (float*)(F.ws + WS_TOKG);
    unsigned* gcnt = (unsigned*)(F.ws + WS_CTL) + CW_ECNT + l * 64;
    const float* gb = gin(p, I_RTGB) + l * 4; const float* eb = gin(p, I_RTEB) + l * 32;
    if (F.tid < 32) lcnt[F.tid] = 0;
    __syncthreads();
    const bool act = F.tid < 256 || (crow0 >= 0 && F.tid < 264);
    const int r = F.tid < 256 ? row0 + F.tid : crow0 + (F.tid - 256);
    int e1 = 0, e2 = 0, r1 = 0, r2 = 0; float ga = 0.f, gbb = 0.f;
    if (act) {
        const float* lg = LOG + (size_t)r * 64;
        const bool latr = F.tid < 256; const int fb = (l * 8 + (row0 >> 13)) * 64;
        const float* SNp = (const float*)(F.ws + WS_SNT) + fb; const float* TNp = SNp + 4 * 8 * 64;
        f32x2 st = (f32x2){0.f, 1.f}; if (latr) st = *(const f32x2*)((const float*)(F.ws + WS_ROWST) + 2 * (size_t)r);
        f32x4 g4 = *(const f32x4*)lg;
        if (latr) { const f32x4 sn = *(const f32x4*)SNp, tn = *(const f32x4*)TNp; g4 = (g4 - sn * st.x) * st.y + tn; } else { g4 = g4 + *(const f32x4*)gb; }
        const float g0 = g4[0], g1 = g4[1], g2 = g4[2], g3 = g4[3];
        int gs = 0; float gm = g0; if (g1 > gm) { gm = g1; gs = 1; } if (g2 > gm) { gm = g2; gs = 2; } if (g3 > gm) { gm = g3; gs = 3; }
        const float pg = 1.0f / (__expf(g0 - gm) + __expf(g1 - gm) + __expf(g2 - gm) + __expf(g3 - gm));
        f32x4 ea = *(const f32x4*)(lg + 4 + gs * 8), ec = *(const f32x4*)(lg + 8 + gs * 8);
        if (latr) { ea = (ea - *(const f32x4*)(SNp + 4 + gs * 8) * st.x) * st.y + *(const f32x4*)(TNp + 4 + gs * 8); ec = (ec - *(const f32x4*)(SNp + 8 + gs * 8) * st.x) * st.y + *(const f32x4*)(TNp + 8 + gs * 8); }
        else { ea = ea + *(const f32x4*)(eb + gs * 8); ec = ec + *(const f32x4*)(eb + gs * 8 + 4); }
        float ev[8];
#pragma unroll
        for (int j = 0; j < 4; ++j) { ev[j] = ea[j]; ev[4 + j] = ec[j]; }
        int i1 = 0; float v1 = ev[0];
#pragma unroll
        for (int j = 1; j < 8; ++j) if (ev[j] > v1) { v1 = ev[j]; i1 = j; }
        int i2 = -1; float v2 = -3.0e38f;
#pragma unroll
        for (int j = 0; j < 8; ++j) if (j != i1 && ev[j] > v2) { v2 = ev[j]; i2 = j; }
        const float t = __expf(v2 - v1); ga = pg / (1.0f + t); gbb = pg * t / (1.0f + t);
        e1 = gs * 8 + i1; e2 = gs * 8 + i2;
        r1 = atomicAdd((int*)(lcnt + e1), 1); r2 = atomicAdd((int*)(lcnt + e2), 1);
    }
    __syncthreads();
    if (F.tid < 32) lbase[F.tid] = (int)atomicAdd(gcnt + F.tid, (unsigned)lcnt[F.tid]);
    __syncthreads();
    if (act) { TE[2 * r] = e1; TE[2 * r + 1] = e2; TR[2 * r] = lbase[e1] + r1; TR[2 * r + 1] = lbase[e2] + r2; TG[2 * r] = ga; TG[2 * r + 1] = gbb; }
    __syncthreads();
}
DI void phase_scatter(const Ctx& F, PP p, int l, int ntok) {
    LAS int* pst = (LAS int*)F.lds; LAS int* pcn = pst + 32; LAS int* cn = pst + 64;
    const int* TE = (const int*)(F.ws + WS_TOKE); int* TR = (int*)(F.ws + WS_TOKR); int* ST = (int*)(F.ws + WS_SLOTTOK); int* TILE = (int*)(F.ws + WS_TILEE) + l * 1024;
    unsigned* gcnt = (unsigned*)(F.ws + WS_CTL) + CW_ECNT + l * 64;
    if (F.tid == 0) { int acc = 0; for (int e = 0; e < 32; ++e) { const int cnt = (int)__hip_atomic_load(gcnt + e, __ATOMIC_RELAXED, __HIP_MEMORY_SCOPE_AGENT); const int pc = (cnt + 255) & ~255; pst[e] = acc; pcn[e] = pc; cn[e] = cnt; acc += pc; } pst[96] = acc; }
    __syncthreads();
    for (int idx = F.vcu * 512 + F.tid; idx < 2 * ntok; idx += F.G * 512) { const int e = TE[idx]; const int slot = pst[e] + TR[idx]; ST[slot] = idx >> 1; TR[idx] = slot; }
    for (int e = F.vcu; e < 32; e += F.G) for (int s = pst[e] + cn[e] + F.tid; s < pst[e] + pcn[e]; s += 512) ST[s] = 0;
    if (F.vcu == 0) { for (int t = F.tid; t < 1024; t += 512) { int ee = 0; for (int e = 0; e < 32; ++e) if (t * 256 >= pst[e] && t * 256 < pst[e] + pcn[e]) ee = e; TILE[t] = (t == 1000) ? (pst[96] >> 8) : ee; } }
    __syncthreads();
}

DI void router_ctx_rows(const Ctx& F, int l) {
    const bf16_t* HA = (const bf16_t*)(F.ws + WS_HA); const bf16_t* WR = (const bf16_t*)(F.ws + WS_WR) + (size_t)l * 256 * 1024; float* LOG = (float*)(F.ws + WS_LOG);
    for (int rr = F.vcu * 8 + F.wave; rr < NCTX; rr += F.G * 8) {
        const int r = NLAT + rr; float hv[16];
#pragma unroll
        for (int j = 0; j < 2; ++j) { const u32x4 q = *(const u32x4*)(HA + (size_t)r * D + 8 * F.lane + 512 * j);
#pragma unroll
            for (int i = 0; i < 4; ++i) { hv[8 * j + 2 * i] = bf_lo(q[i]); hv[8 * j + 2 * i + 1] = bf_hi(q[i]); } }
        float mine = 0.f;
        for (int n0 = 0; n0 < 36; n0 += 6) { u32x4 q[6][2];
#pragma unroll
            for (int t = 0; t < 6; ++t)
#pragma unroll
                for (int j = 0; j < 2; ++j) q[t][j] = *(const u32x4*)(WR + (size_t)(n0 + t) * 1024 + 8 * F.lane + 512 * j);
            float a[6];
#pragma unroll
            for (int t = 0; t < 6; ++t) { a[t] = 0.f;
#pragma unroll
                for (int j = 0; j < 2; ++j)
#pragma unroll
                    for (int i = 0; i < 4; ++i) { a[t] += hv[8 * j + 2 * i] * bf_lo(q[t][j][i]); a[t] += hv[8 * j + 2 * i + 1] * bf_hi(q[t][j][i]); } }
#pragma unroll
            for (int t = 0; t < 6; ++t) a[t] = wave_sum(a[t]);
#pragma unroll
            for (int t = 0; t < 6; ++t) mine = (F.lane == n0 + t) ? a[t] : mine; }
        if (F.lane < 36) LOG[(size_t)r * 64 + F.lane] = mine;
    }
}

constexpr int NPHASE = 2 + 9 * DEPTH;
#ifndef MK_MULTI_LAUNCH
#define MK_MULTI_LAUNCH 0
#endif

__global__ void __launch_bounds__(512, 2) mega_fwd(Params p) {
    extern __shared__ __attribute__((aligned(16))) unsigned char lds_raw[];
    LAS unsigned char* const lds0 = (LAS unsigned char*)lds_raw;
    const int wave0 = __builtin_amdgcn_readfirstlane((int)threadIdx.x >> 6);
#define LEADER() (wave0 == 0 && lane_id_v() == 0)
#define MKCTX() Ctx F; { int t_ = wave0 * 64 + lane_id_v(); F.tid = t_; F.lane = t_ & 63; F.wave = __builtin_amdgcn_readfirstlane(t_ >> 6); \
        int g_ = gridDim.x, bx_ = blockIdx.x; asm volatile("" : "+s"(g_), "+s"(bx_)); F.G = g_; F.bx = bx_; F.vcu = (g_ % 8 == 0) ? (bx_ % 8) * (g_ / 8) + bx_ / 8 : bx_; \
        GAS unsigned char* w_ = (GAS unsigned char*)p.ws; GAS float* o_ = (GAS float*)p.out; asm volatile("" : "+s"(w_), "+s"(o_)); F.ws = (unsigned char*)w_; F.out = (float*)o_; F.lds = lds0; } \
        PP pk = (PP)__builtin_amdgcn_kernarg_segment_ptr(); asm volatile("" : "+s"(pk));
    volatile LAS unsigned* MISC = (volatile LAS unsigned*)(lds0 + MISC_OFF);
    if (wave0 == 0) MISC[lane_id_v()] = 0u;
    __syncthreads();
    unsigned* ctl = (unsigned*)(p.ws + WS_CTL);
    XcdBarrier bar; bar.bar = ctl + CW_BAR; bar.x = 0; bar.st = MISC + 8;
    if (p.ph_hi - p.ph_lo > 1) bar = xcd_barrier_post(ctl + CW_BAR, MISC + 8, LEADER());
#ifndef EN_MASK
#define EN_MASK 0xFFFF
#endif
#define EN(b) ((EN_MASK >> (b)) & 1)
#ifndef REP_MASK
#define REP_MASK 0
#endif
#define REPN(b) (((REP_MASK >> (b)) & 1) ? 2 : 1)
#define RUN(k) (p.ph_lo <= (k) && (k) < p.ph_hi)
#define SEAM(k) do { if (RUN(k) && RUN((k) + 1)) xcd_barrier(bar, LEADER()); } while (0)

    if (RUN(0) && EN(11)) for (int rep = 0; rep < REPN(11); ++rep) { MKCTX(); phase_prologue_a(F, pk); } SEAM(0);
    if (RUN(1) && EN(12)) for (int rep = 0; rep < REPN(12); ++rep) { { MKCTX(); router_fold_weights(F, pk); } MKCTX(); phase_rows<0, true>(F, pk, 0, NT); } SEAM(1);

    for (int l = 0; l < DEPTH; ++l) {
        const int pb = 2 + 9 * l;
        const bool lastl = (l == DEPTH - 1);
        const int nrows = lastl ? NLAT : NT;
        if (RUN(pb + 0) && EN(0)) for (int rep = 0; rep < REPN(0); ++rep) { MKCTX();
            pg8::StaticOrder S; S.init(NLAT, DIN, 1024, F.G, F.bx);
            { LAS float* rl = (LAS float*)(F.lds + ROPE_OFF); const float* rg = (const float*)(F.ws + WS_ROPE); for (int i = F.tid; i < 128 * 32; i += 512) rl[i] = rg[i]; }
            __syncthreads();
            pg8::EpiInproj E{(bf16_t*)(F.ws + WS_U), (bf16_t*)(F.ws + WS_G), (bf16_t*)(F.ws + WS_Q), (bf16_t*)(F.ws + WS_KB), (bf16_t*)(F.ws + WS_VT), (bf16_t*)(F.ws + WS_VTC), (const LAS float*)(F.lds + ROPE_OFF)};
            pg8::gemm_phase<pg8::EpiInproj, pg8::StaticOrder>(F.lds, F.tid, (const bf16_t*)(F.ws + WS_HA), (const bf16_t*)(F.ws + WS_WIN) + (size_t)l * DIN * 1024, 1024, S, E);
        } SEAM(pb + 0);
        if (RUN(pb + 1) && EN(1)) for (int rep = 0; rep < REPN(1); ++rep) { MKCTX(); phase_scan(F, pk, l); } SEAM(pb + 1);
        if (RUN(pb + 2) && EN(2)) for (int rep = 0; rep < REPN(2); ++rep) { MKCTX(); phase_attn(F, pk, l); } SEAM(pb + 2);
        if (RUN(pb + 3) && EN(3)) for (int rep = 0; rep < REPN(3); ++rep) { MKCTX();
            pg8::StaticOrder S; S.init(NLAT, 1024, 1024, F.G, F.bx);
            pg8::EpiPlainBf16 E{(bf16_t*)(F.ws + WS_Y), D, 1.0f};
            pg8::gemm_phase<pg8::EpiPlainBf16, pg8::StaticOrder>(F.lds, F.tid, (const bf16_t*)(F.ws + WS_HA), (const bf16_t*)(F.ws + WS_WOUT) + (size_t)l * 1024 * 1024, 1024, S, E);
        } SEAM(pb + 3);
        if (RUN(pb + 4) && EN(4)) for (int rep = 0; rep < REPN(4); ++rep) { MKCTX(); phase_rows<1, false>(F, pk, l, nrows);
            asm volatile("s_waitcnt vmcnt(0)" ::: "memory"); __syncthreads();
            { pg8::OneUnit S; S.pm = F.vcu; S.pn = 0; S.K = 1024; pg8::EpiRouter E{(float*)(F.ws + WS_LOG)};
              pg8::gemm_phase<pg8::EpiRouter, pg8::OneUnit, false, true>(F.lds, F.tid, (const bf16_t*)(F.ws + WS_XB), (const bf16_t*)(F.ws + WS_WRB) + (size_t)(l * 8 + (F.vcu >> 5)) * 64 * 1024, 1024, S, E); }
            if (!lastl) router_ctx_rows(F, l);
            asm volatile("s_waitcnt vmcnt(0)" ::: "memory"); __syncthreads();
            route_block(F, pk, l, 256 * F.vcu, lastl ? -1 : NLAT + 8 * F.vcu);
        } SEAM(pb + 4);
        if (RUN(pb + 5) && EN(7)) for (int rep = 0; rep < REPN(7); ++rep) { MKCTX(); phase_scatter(F, pk, l, nrows); if (l >= 1) bg_moe_weights(F, pk, l, -1);   } SEAM(pb + 5);
        if (RUN(pb + 6) && EN(8)) for (int rep = 0; rep < REPN(8); ++rep) { MKCTX();
            const int* TILE = (const int*)(F.ws + WS_TILEE) + l * 1024; const int ntiles = __builtin_amdgcn_readfirstlane(TILE[1000]);
            LAS int* toktab = (LAS int*)(F.lds + TOKTAB_OFF);
            pg8::MoeOrder<true> S; S.ntiles = ntiles; S.nN = 4; S.G = F.G; S.c = F.vcu; S.K = 512; S.tile_e = TILE; S.estride = (size_t)1024 * 1024; S.toktab = toktab;
            { const int* ST = (const int*)(F.ws + WS_SLOTTOK); pg8::Unit u; for (int i = 0; i < 12 && S.next(i, u); ++i) if (F.tid < 256) toktab[i * 256 + F.tid] = ST[u.pm * 256 + F.tid]; }
            __syncthreads();
            pg8::EpiSwigluF8 E{(unsigned char*)(F.ws + WS_HMOE)};
            pg8::gemm_phase<pg8::EpiSwigluF8, pg8::MoeOrder<true>, true>(F.lds, F.tid, (const bf16_t*)(F.ws + WS_HA8), (const bf16_t*)(F.ws + WS_W13 + (size_t)l * NE * 1024 * 1024), 512, S, E);
            if ((ntiles * 4) % F.G != 0 && F.vcu >= (ntiles * 4) % F.G) bg_moe_weights(F, pk, l + 1, 4);
        } SEAM(pb + 6);
        if (RUN(pb + 7) && EN(9)) for (int rep = 0; rep < REPN(9); ++rep) { MKCTX();
            const int* TILE = (const int*)(F.ws + WS_TILEE) + l * 1024; const int ntiles = __builtin_amdgcn_readfirstlane(TILE[1000]);
            pg8::MoeOrder<false> S; S.ntiles = ntiles; S.nN = 4; S.G = F.G; S.c = F.vcu; S.K = 256; S.tile_e = TILE; S.estride = (size_t)1024 * DE; S.toktab = nullptr;
            pg8::EpiPlainF8 E{(unsigned char*)(F.ws + WS_YMOE), D, pg8::F8_SY / (pg8::F8_SH * pg8::F8_SW2)};
            pg8::gemm_phase<pg8::EpiPlainF8, pg8::MoeOrder<false>, true>(F.lds, F.tid, (const bf16_t*)(F.ws + WS_HMOE), (const bf16_t*)(F.ws + WS_W2 + (size_t)l * NE * 1024 * DE), 256, S, E);
            if ((ntiles * 4) % F.G != 0 && F.vcu >= (ntiles * 4) % F.G) bg_moe_weights(F, pk, l + 1, 3);
        } SEAM(pb + 7);
        if (RUN(pb + 8) && EN(10)) for (int rep = 0; rep < REPN(10); ++rep) { MKCTX(); if (lastl) phase_rows<2, false>(F, pk, l, nrows); else phase_rows<2, true>(F, pk, l, nrows); } SEAM(pb + 8);
    }
#undef RUN
#undef SEAM
}

extern "C" void kernel_launch(void* const* d_in, const int* in_sizes, int n_in, void* d_out, int out_size, void* d_ws, size_t ws_size, hipStream_t stream) {
    static int grid = 0;
    if (grid == 0) {
        if (n_in != 29 || out_size != NLAT * D || ws_size < WS_END) { fprintf(stderr, "kernel_launch: unexpected shapes (n_in %d out %d ws %zu, need %zu)\n", n_in, out_size, ws_size, (size_t)WS_END); grid = -1; return; }
        int dev = 0, cus = 0, per_cu = 0;
        if (hipGetDevice(&dev) != hipSuccess || hipDeviceGetAttribute(&cus, hipDeviceAttributeMultiprocessorCount, dev) != hipSuccess) { grid = -1; return; }
        if (hipFuncSetAttribute((const void*)mega_fwd, hipFuncAttributeMaxDynamicSharedMemorySize, LDS_BYTES) != hipSuccess) { fprintf(stderr, "kernel_launch: hipFuncSetAttribute failed\n"); grid = -1; return; }
        if (hipOccupancyMaxActiveBlocksPerMultiprocessor(&per_cu, (const void*)mega_fwd, 512, LDS_BYTES) != hipSuccess || per_cu < 1) fprintf(stderr, "kernel_launch: occupancy query says %d\n", per_cu);
        (void)hipGetLastError();
        grid = cus;
    }
    if (grid < 0) return;
    (void)hipMemsetAsync((char*)d_ws + WS_CTL, 0, CTL_ZERO_BYTES, stream);
    Params p{};
    for (int i = 0; i < 29; ++i) p.in[i] = (const float*)d_in[i];
    p.out = (float*)d_out; p.ws = (unsigned char*)d_ws;
#if MK_MULTI_LAUNCH
    for (int k = 0; k < NPHASE; ++k) { p.ph_lo = k; p.ph_hi = k + 1; hipLaunchKernelGGL(mega_fwd, dim3(grid), dim3(512), LDS_BYTES, stream, p); }
#else
    p.ph_lo = 0; p.ph_hi = NPHASE;
    hipLaunchKernelGGL(mega_fwd, dim3(grid), dim3(512), LDS_BYTES, stream, p);
#endif
    const hipError_t le = hipPeekAtLastError();
    if (le != hipSuccess) fprintf(stderr, "kernel_launch: launch failed: %s\n", hipGetErrorName(le));
}
```

```cpp
#include <hip/hip_runtime.h>
#include <cstdio>
#include <cstdint>

#define DI __device__ __forceinline__
#define LAS __attribute__((address_space(3)))
#define GAS __attribute__((address_space(1)))

typedef unsigned short bf16_t;
typedef short bf16x8 __attribute__((ext_vector_type(8)));
typedef short s16x4 __attribute__((ext_vector_type(4)));
typedef float f32x4 __attribute__((ext_vector_type(4)));
typedef float f32x2 __attribute__((ext_vector_type(2)));
typedef float f32x16 __attribute__((ext_vector_type(16)));
typedef unsigned u32x4 __attribute__((ext_vector_type(4)));
typedef unsigned u32x2 __attribute__((ext_vector_type(2)));

constexpr int D = 1024, NB = 8, SEQ = 8192, DEPTH = 4, CL = 256;
constexpr int NLAT = NB * SEQ, NCTX = NB * CL, NT = NLAT + NCTX;
constexpr int DIN = 1792, DR = 512;
constexpr int NE = 32, DE = 512;
constexpr int MPAD = 143360;
constexpr float ALPHA = 1.6817928305074292f;
constexpr float LN_EPS = 1e-6f;
constexpr float LOG2E = 1.4426950408889634f;

constexpr size_t MiB = 1u << 20;
constexpr size_t WS_CTL = 0, CTL_ZERO_BYTES = 1 * MiB;
constexpr size_t WS_MOD = 1 * MiB;
constexpr size_t WS_ROPE = 2 * MiB;
constexpr size_t WS_SNT = 2 * MiB + 131072;
constexpr size_t WS_ROWST = 2 * MiB + 262144;
constexpr size_t WS_TILEE = 2 * MiB + 65536;
constexpr size_t WS_WIN = 3 * MiB;
constexpr size_t WS_WOUT = 17 * MiB;
constexpr size_t WS_WR = 25 * MiB;
constexpr size_t WS_W13 = 27 * MiB;
constexpr size_t WS_XB = 155 * MiB;
constexpr size_t WS_W2 = 283 * MiB;
constexpr size_t WS_WRB = 347 * MiB;
constexpr size_t WS_DUMMY = 352 * MiB;
constexpr size_t WS_XC = 411 * MiB;
constexpr size_t WS_HA = 419 * MiB;
constexpr size_t WS_LOG = 551 * MiB;
constexpr size_t WS_TOKE = 568 * MiB;
constexpr size_t WS_TOKG = 569 * MiB;
constexpr size_t WS_TOKR = 570 * MiB;
constexpr size_t WS_SLOTTOK = 571 * MiB;
constexpr size_t WS_R = 572 * MiB;
constexpr size_t WS_U = WS_R, WS_G = WS_R + 66 * MiB, WS_Q = WS_R + 132 * MiB, WS_KB = WS_R + 198 * MiB, WS_VT = WS_R + 215 * MiB;
constexpr size_t WS_VTC = WS_VT + 16 * MiB;
constexpr size_t WS_HF = WS_R + 232 * MiB, WS_HB = WS_R + 298 * MiB, WS_Y = WS_R + 364 * MiB;
constexpr size_t WS_XCV = WS_R + 364 * MiB;
constexpr size_t WS_HMOE = WS_R, WS_YMOE = WS_R + 232 * MiB;
constexpr size_t WS_HA8 = WS_R + 232 * MiB;
constexpr size_t WS_END = WS_R + 496 * MiB;
static_assert(WS_KB + (size_t)NT * 128 * 2 <= WS_VT && WS_VTC + (size_t)NB * 2 * 64 * CL * 2 <= WS_HF && WS_Y + (size_t)NT * D * 2 <= WS_END, "ws map");
static_assert(WS_W13 + (size_t)DEPTH * NE * 1024 * 1024 <= WS_XB && WS_XB + (size_t)NLAT * D * 2 <= WS_W2, "ws map xb");
static_assert(WS_HMOE + (size_t)MPAD * DE <= WS_HA8 && WS_VTC + (size_t)NB * 2 * 64 * CL * 2 <= WS_YMOE && WS_YMOE + (size_t)MPAD * D <= WS_END, "ws map moe");
constexpr int CW_BAR = 4096;
constexpr int CW_ECNT = 8192;
constexpr int CW_CTXIN = 16384;
constexpr int CW_SCANX = 32768;
constexpr int CW_BGQ = 24576;
constexpr int CW_CTXMIX = 12288;

constexpr int LDS_BYTES = 148480;
constexpr int TOKTAB_OFF = 131072;
constexpr int ROPE_OFF = 131072;
constexpr int MISC_OFF = 131072 + 16384;

DI unsigned f2bf(float f) { unsigned u = __float_as_uint(f); return (u + 0x7fffu + ((u >> 16) & 1u)) >> 16; }
DI unsigned pk2(float lo, float hi) { unsigned r; asm("v_cvt_pk_bf16_f32 %0, %1, %2" : "=v"(r) : "v"(lo), "v"(hi)); return r; }
typedef _Float16 f16x2 __attribute__((ext_vector_type(2)));
DI unsigned pkh2(float lo, float hi) { const f16x2 t = {(_Float16)lo, (_Float16)hi}; return __builtin_bit_cast(unsigned, t); }
DI f32x2 unpkh2(unsigned u) { const f16x2 t = __builtin_bit_cast(f16x2, u); return (f32x2){(float)t.x, (float)t.y}; }
DI float bf_lo(unsigned u) { return __uint_as_float(u << 16); }
DI float bf_hi(unsigned u) { return __uint_as_float(u & 0xffff0000u); }
DI float bf2f(bf16_t b) { return __uint_as_float(((unsigned)b) << 16); }
template <int CTRL, int ROWMASK = 0xf> DI float dpp_mov(float v) { return __builtin_bit_cast(float, __builtin_amdgcn_update_dpp(0, __builtin_bit_cast(int, v), CTRL, ROWMASK, 0xf, ROWMASK == 0xf)); }
DI float wave_sum(float v) {
    v += dpp_mov<0xB1>(v); v += dpp_mov<0x4E>(v); v += dpp_mov<0x141>(v); v += dpp_mov<0x140>(v);
    v += dpp_mov<0x142, 0xa>(v); v += dpp_mov<0x143, 0xc>(v);
    return __builtin_bit_cast(float, __builtin_amdgcn_readlane(__builtin_bit_cast(int, v), 63));
}
DI float xor32_max(float v) { float a = v, b = v; asm("s_nop 1\n\tv_permlane32_swap_b32 %0, %1" : "+v"(a), "+v"(b)); return fmaxf(a, b); }
DI float xor32_sum(float v) { float a = v, b = v; asm("s_nop 1\n\tv_permlane32_swap_b32 %0, %1" : "+v"(a), "+v"(b)); return a + b; }
DI int lane_id_v() { int l; asm volatile("v_mbcnt_lo_u32_b32 %0, -1, 0\n\tv_mbcnt_hi_u32_b32 %0, -1, %0" : "=v"(l)); return l; }
DI void lds_barrier() { asm volatile("s_waitcnt lgkmcnt(0)" ::: "memory"); __builtin_amdgcn_s_barrier(); asm volatile("" ::: "memory"); }
DI float f8clamp(float x) { return __builtin_amdgcn_fmed3f(x, -448.0f, 448.0f); }
DI float fast_exp2(float x) { return __builtin_amdgcn_exp2f(x); }
DI float fast_rcp(float x) { return __builtin_amdgcn_rcpf(x); }
DI float sigmoidf_(float x) { return fast_rcp(1.0f + fast_exp2(-x * LOG2E)); }
DI float gelu_tanh(float x) {
    const float u = 0.7978845608028654f * (x + 0.044715f * x * x * x);
    return x * sigmoidf_(2.0f * u);
}

DI unsigned swap1(unsigned v) { return (unsigned)__builtin_amdgcn_update_dpp(0, (int)v, 0xB1, 0xf, 0xf, true); }
DI u32x4 swap1(u32x4 v) { return (u32x4){swap1(v.x), swap1(v.y), swap1(v.z), swap1(v.w)}; }
DI u32x2 swap1(u32x2 v) { return (u32x2){swap1(v.x), swap1(v.y)}; }
DI int wblk(int nb) { return (nb & ~7) | ((nb & 1) * 4 + ((nb >> 1) & 3)); }

#define XB_TMO      128
#define XB_XCNT(j)  (256  + 64 * (j))
#define XB_XSUB(j)  (1280 + 64 * (j))
#define XB_XGEN(j)  (2304 + 64 * (j))
#define XB_TOP      3328
#define XB_TOPGEN   3392
#define XCD_BAR_WORDS 3456
#define XB_SPIN_CAP (1u << 18)

__device__ __forceinline__ unsigned xb_ld(unsigned* p)              { return __hip_atomic_load(p, __ATOMIC_RELAXED, __HIP_MEMORY_SCOPE_AGENT); }
__device__ __forceinline__ unsigned xb_add(unsigned* p, unsigned v) { return __hip_atomic_fetch_add(p, v, __ATOMIC_RELAXED, __HIP_MEMORY_SCOPE_AGENT); }
__device__ __forceinline__ unsigned xb_xcc_id() { return (unsigned)__builtin_amdgcn_s_getreg((3 << 11) | 20) & 0xFu; }
#define XB_SPIN(cond, bar) do { unsigned _sp = 0; while (cond) { __builtin_amdgcn_s_sleep(1); \
    if ((++_sp & 255u) == 0u) { if (xb_ld(&(bar)[XB_TMO])) break; if (_sp > XB_SPIN_CAP) { atomicAdd(&(bar)[XB_TMO], 1u); break; } } } } while (0)

struct XcdBarrier { unsigned* bar; unsigned x; volatile LAS unsigned* st; };

__device__ __forceinline__ XcdBarrier xcd_barrier_post(unsigned* bar, volatile LAS unsigned* st, const bool leader) {
    XcdBarrier b; b.bar = bar; b.x = xb_xcc_id(); b.st = st;
    if (leader) (void)xb_add(&bar[XB_XCNT(b.x)], 1u);
    return b;
}
__device__ __forceinline__ void xcd_barrier_complete(unsigned* bar, unsigned x, unsigned& nloc, unsigned& nx) {
    const unsigned G = gridDim.x * gridDim.y * gridDim.z;
    unsigned sum, cnt, mine, sp = 0u;
    for (;;) {
        sum = 0u; cnt = 0u; mine = 0u;
        unsigned cv[16];
#pragma unroll
        for (unsigned j = 0; j < 16; ++j) asm volatile("global_load_dword %0, %1, off sc1" : "=v"(cv[j]) : "v"(&bar[XB_XCNT(j)]) : "memory");
        asm volatile("s_waitcnt vmcnt(0)" : "+v"(cv[0]), "+v"(cv[1]), "+v"(cv[2]), "+v"(cv[3]), "+v"(cv[4]), "+v"(cv[5]), "+v"(cv[6]), "+v"(cv[7]), "+v"(cv[8]), "+v"(cv[9]), "+v"(cv[10]), "+v"(cv[11]), "+v"(cv[12]), "+v"(cv[13]), "+v"(cv[14]), "+v"(cv[15]) :: "memory");
#pragma unroll
        for (unsigned j = 0; j < 16; ++j) { const unsigned c = cv[j]; sum += c; cnt += (c > 0u) ? 1u : 0u; mine = (j == x) ? c : mine; }
        if (sum == G) break;
        __builtin_amdgcn_s_sleep(1);
        if ((++sp & 255u) == 0u) { if (xb_ld(&bar[XB_TMO])) break; if (sp > XB_SPIN_CAP) { atomicAdd(&bar[XB_TMO], 1u); break; } }
    }
    nloc = mine > 0u ? mine : 1u; nx = cnt > 0u ? cnt : 1u;
}
__device__ __forceinline__ void xcd_barrier(const XcdBarrier& b, const bool leader) {
    asm volatile("s_waitcnt vmcnt(0)" ::: "memory");
    __syncthreads();
    if (leader) {
        unsigned* bar = b.bar;
        __builtin_amdgcn_s_waitcnt(0);
        unsigned nloc = b.st[0], nx = b.st[1];
        if (nloc == 0u) { xcd_barrier_complete(bar, b.x, nloc, nx); b.st[0] = nloc; b.st[1] = nx; }
        const unsigned old = xb_add(&bar[XB_XSUB(b.x)], 1u);
        const unsigned gen = old / nloc;
        if (old + 1u == (gen + 1u) * nloc) {
            __builtin_amdgcn_fence(__ATOMIC_RELEASE, "agent");
            asm volatile("s_waitcnt vmcnt(0)" ::: "memory");
            const unsigned og = xb_add(&bar[XB_TOP], 1u);
            const unsigned tg = og / nx;
            if (og + 1u == (tg + 1u) * nx) xb_add(&bar[XB_TOPGEN], 1u);
            else XB_SPIN(xb_ld(&bar[XB_TOPGEN]) == tg, bar);
            __builtin_amdgcn_fence(__ATOMIC_ACQUIRE, "agent");
            xb_add(&bar[XB_XGEN(b.x)], 1u);
            asm volatile("s_waitcnt vmcnt(0)" ::: "memory");
        } else {
            XB_SPIN(xb_ld(&bar[XB_XGEN(b.x)]) == gen, bar);
            __builtin_amdgcn_fence(__ATOMIC_ACQUIRE, "agent");
            asm volatile("s_waitcnt vmcnt(0)" ::: "memory");
        }
    }
    __syncthreads();
}

namespace pg8 {
constexpr int BM = 256, BK = 64, HALF = 128, HTB = HALF * BK * 2, STAGE_BYTES = 8 * HTB, NXCD = 8, WGM = 8;
__host__ __device__ __forceinline__ int lds_byte(int r, int c) { const int st = (r >> 4) * 2 + (c >> 5), rr = r & 15, cc = c & 31, ob = rr * 64 + cc * 2; return st * 1024 + (ob ^ (((ob >> 9) & 1) << 5)); }
__host__ __device__ __forceinline__ void stage_rc(int b, int& R, int& C) { const int st = b / 1024, sb = b % 1024, swz = sb ^ (((sb >> 9) & 1) << 5); R = (st >> 1) * 16 + swz / 64; C = (st & 1) * 32 + (swz % 64) / 2; }

struct Unit { int pm, pn; };

struct StaticOrder {
    static constexpr bool GATHER = false;
    int nM, nN, nwg, G, c, K;
    __device__ __forceinline__ void init(int M, int N, int K_, int G_, int c_) { nM = M / BM; nN = N / BM; nwg = nM * nN; G = G_; c = c_; K = K_; }
    __device__ __forceinline__ bool next(int i, Unit& u) const {
        const long L = (long)i * G + c; if (L >= nwg) return false;
        int wgid = (int)L; { const int q = nwg / NXCD, r = nwg % NXCD, xcd = wgid % NXCD, off = wgid / NXCD; wgid = (xcd < r ? xcd * (q + 1) : r * (q + 1) + (xcd - r) * q) + off; }
        const int nig = WGM * nN, gid = wgid / nig, fm = gid * WGM, gsz = (nM - fm) < WGM ? (nM - fm) : WGM;
        u.pm = fm + ((wgid % nig) % gsz); u.pn = (wgid % nig) / gsz; return true;
    }
    __device__ __forceinline__ size_t b_off(const Unit& u) const { return (size_t)u.pn * BM * K * 2; }
    __device__ __forceinline__ LAS const int* tok(int) const { return nullptr; }
};
struct OneUnit {
    static constexpr bool GATHER = false; int pm, pn, K;
    __device__ __forceinline__ bool next(int i, Unit& u) const { if (i != 0) return false; u.pm = pm; u.pn = pn; return true; }
    __device__ __forceinline__ size_t b_off(const Unit& u) const { return (size_t)u.pn * BM * K * 2; }
    __device__ __forceinline__ LAS const int* tok(int) const { return nullptr; }
};
template <bool GATHER_> struct MoeOrder {
    static constexpr bool GATHER = GATHER_;
    int ntiles, nN, G, c, K; const int* tile_e; size_t estride; LAS const int* toktab;
    __device__ __forceinline__ bool next(int i, Unit& u) const { const long L = (long)i * G + c; if (L >= (long)ntiles * nN) return false; u.pm = (int)(L / nN); u.pn = (int)(L % nN); return true; }
    __device__ __forceinline__ size_t b_off(const Unit& u) const { return (size_t)__builtin_amdgcn_readfirstlane(tile_e[u.pm]) * estride + (size_t)u.pn * BM * K * 2; }
    __device__ __forceinline__ LAS const int* tok(int ui) const { return toktab + ui * 256; }
};

typedef int i32x8 __attribute__((ext_vector_type(8)));
typedef _Float16 f16x8 __attribute__((ext_vector_type(8)));
typedef int i32x4 __attribute__((ext_vector_type(4)));
template <class Epi, class Sched, bool FP8 = false, bool F16 = false>
__device__ __forceinline__ void gemm_phase(LAS unsigned char* lds, const int tid, const bf16_t* Ap, const bf16_t* Btp, const int K, const Sched& S, const Epi& E) {
    const int wid = __builtin_amdgcn_readfirstlane(tid >> 6), lane = tid & 63, wr = wid >> 2, wc = wid & 3, fr = lane & 15, fq = lane >> 4;
    const int nt = K / BK;
    unsigned voffA[2], voffB[2];
#pragma unroll
    for (int i = 0; i < 2; ++i) { int R, C; stage_rc(tid * 16 + i * 8192, R, C); voffA[i] = (unsigned)(R * K + C) * 2u; voffB[i] = voffA[i]; }
    unsigned gvC[2][2], gvN[2][2];
    const size_t kstep = (size_t)(BK * 2);
    const size_t hstep = (size_t)HALF * K * 2;
    const size_t tstep = 2 * hstep;
    const unsigned ldsw = (unsigned)wid * 1024u;
    const int aoff = lds_byte(wr * 64 + fr, fq * 8), boff = lds_byte(wc * 32 + fr, fq * 8);
#define PG8_SA(b, h) (((b) * 2 + (h)) * HTB)
#define PG8_SB(b, h) ((4 + (b) * 2 + (h)) * HTB)
#define PG8_STAGE2(bufoff, gbase, v0, v1) do { \
        __builtin_amdgcn_global_load_lds((const unsigned*)((const char*)(gbase) + (v0)), (LAS unsigned*)(lds + (bufoff) + ldsw), 16, 0, 0); \
        __builtin_amdgcn_global_load_lds((const unsigned*)((const char*)(gbase) + (v1)), (LAS unsigned*)(lds + (bufoff) + ldsw + 8192), 16, 0, 0); } while (0)
#define PG8_STAGEB(bufoff, gbase) PG8_STAGE2(bufoff, gbase, voffB[0], voffB[1])
#define PG8_STAGEA(bufoff, sel, h, kb) do { if constexpr (Sched::GATHER) { const unsigned _v0 = (sel) ? gvN[h][0] : gvC[h][0], _v1 = (sel) ? gvN[h][1] : gvC[h][1]; PG8_STAGE2(bufoff, (const char*)Ap + (kb), _v0, _v1); } \
        else { PG8_STAGE2(bufoff, ((sel) ? nA : cA) + (size_t)(h) * hstep + (kb), voffA[0], voffA[1]); } } while (0)
#define PG8_LDA(dst, b, h) do { _Pragma("unroll") for (int m = 0; m < 4; ++m) _Pragma("unroll") for (int k = 0; k < 2; ++k) dst[m][k] = *(const LAS bf16x8*)(lds + PG8_SA(b, h) + aoff + m * 2048 + k * 1024); } while (0)
#define PG8_LDB(dst, b, h) do { _Pragma("unroll") for (int n = 0; n < 2; ++n) _Pragma("unroll") for (int k = 0; k < 2; ++k) dst[n][k] = *(const LAS bf16x8*)(lds + PG8_SB(b, h) + boff + n * 2048 + k * 1024); } while (0)
#define PG8_CAT8(x0, x1) __builtin_shufflevector(__builtin_bit_cast(i32x4, x0), __builtin_bit_cast(i32x4, x1), 0, 1, 2, 3, 4, 5, 6, 7)
#define PG8_MMA(ai, bj, At, Bt) do { __builtin_amdgcn_s_setprio(1); if constexpr (FP8) { _Pragma("unroll") for (int m = 0; m < 4; ++m) _Pragma("unroll") for (int n = 0; n < 2; ++n) { \
            const i32x8 _a = PG8_CAT8(Bt[n][0], Bt[n][1]), _b = PG8_CAT8(At[m][0], At[m][1]); \
            asm volatile("v_mfma_scale_f32_16x16x128_f8f6f4 %0, %1, %2, %0, %3, %3 op_sel_hi:[0,0,0]" : "+v"(acc[ai][bj][m][n]) : "v"(_a), "v"(_b), "v"(f8one)); } }   \
        else if constexpr (F16) { _Pragma("unroll") for (int m = 0; m < 4; ++m) _Pragma("unroll") for (int n = 0; n < 2; ++n) _Pragma("unroll") for (int k = 0; k < 2; ++k) \
        acc[ai][bj][m][n] = __builtin_amdgcn_mfma_f32_16x16x32_f16(__builtin_bit_cast(f16x8, Bt[n][k]), __builtin_bit_cast(f16x8, At[m][k]), acc[ai][bj][m][n], 0, 0, 0); } \
        else { _Pragma("unroll") for (int m = 0; m < 4; ++m) _Pragma("unroll") for (int n = 0; n < 2; ++n) _Pragma("unroll") for (int k = 0; k < 2; ++k) \
        acc[ai][bj][m][n] = __builtin_amdgcn_mfma_f32_16x16x32_bf16(Bt[n][k], At[m][k], acc[ai][bj][m][n], 0, 0, 0); } __builtin_amdgcn_s_setprio(0); } while (0)
#define PG8_WAIT_V(n) asm volatile("s_waitcnt vmcnt(" #n ")" ::: "memory")
#define PG8_WAIT_L(n) asm volatile("s_waitcnt lgkmcnt(" #n ")" ::: "memory")
#define PG8_BAR __builtin_amdgcn_s_barrier()
#define PG8_SCHED __builtin_amdgcn_sched_barrier(0)
#define PG8_GV(dst, ui_) do { if constexpr (Sched::GATHER) { LAS const int* _tt = S.tok(ui_); _Pragma("unroll") for (int _h = 0; _h < 2; ++_h) _Pragma("unroll") for (int _i = 0; _i < 2; ++_i) \
        { int _R, _C; stage_rc(tid * 16 + _i * 8192, _R, _C); dst[_h][_i] = ((unsigned)_tt[_h * 128 + _R] * (unsigned)K + (unsigned)_C) * 2u; } } } while (0)
    Unit cur, nxt; int ui = 0;
    if (!S.next(0, cur)) return;
    int f8one = 0x7f7f7f7f; asm volatile("" : "+v"(f8one));
    f32x4 acc[2][2][4][2];
#pragma unroll
    for (int a = 0; a < 2; ++a)
#pragma unroll
        for (int b = 0; b < 2; ++b)
#pragma unroll
            for (int m = 0; m < 4; ++m)
#pragma unroll
                for (int n = 0; n < 2; ++n) acc[a][b][m][n] = (f32x4){0.f, 0.f, 0.f, 0.f};
    bf16x8 At[4][2], B0[2][2], B1[2][2];
    const char* cA = (const char*)Ap + (size_t)cur.pm * tstep; const char* cB = (const char*)Btp + S.b_off(cur);
    const char* nA = cA; const char* nB = cB;
    PG8_GV(gvC, 0);
#pragma unroll
    for (int _h = 0; _h < 2; ++_h) { gvN[_h][0] = gvC[_h][0]; gvN[_h][1] = gvC[_h][1]; }
    asm volatile("" ::: "memory");
    PG8_STAGEB(PG8_SB(0, 0), cB); PG8_STAGEA(PG8_SA(0, 0), false, 0, 0); PG8_STAGEB(PG8_SB(0, 1), cB + hstep); PG8_STAGEA(PG8_SA(0, 1), false, 1, 0);
    if (wr == 1) PG8_BAR;
    PG8_WAIT_V(4); PG8_BAR;
    PG8_STAGEB(PG8_SB(1, 0), cB + kstep); PG8_STAGEA(PG8_SA(1, 0), false, 0, kstep); PG8_STAGEB(PG8_SB(1, 1), cB + hstep + kstep);
    PG8_WAIT_V(6); PG8_BAR;
    for (;;) {
        const bool has_next = S.next(ui + 1, nxt);
        nA = has_next ? (const char*)Ap + (size_t)nxt.pm * tstep : cA; nB = has_next ? (const char*)Btp + S.b_off(nxt) : cB;
        if (has_next) { PG8_GV(gvN, ui + 1); }
#pragma unroll 1
        for (int t = 0; t < nt; t += 2) {
            const bool last = (t == nt - 2);
            const size_t k1 = (size_t)(t + 1) * kstep;
            const size_t k2 = last ? 0 : (size_t)(t + 2) * kstep;
            const char* b2 = last ? nB : cB + (size_t)(t + 2) * kstep;
            const size_t k3 = k2 + kstep; const char* b3 = b2 + kstep;
            PG8_LDB(B0, 0, 0); PG8_SCHED; PG8_LDA(At, 0, 0); PG8_STAGEA(PG8_SA(1, 1), false, 1, k1);
            PG8_WAIT_L(8); PG8_BAR; PG8_WAIT_L(0); PG8_MMA(0, 0, At, B0); PG8_BAR; PG8_SCHED;
            PG8_LDB(B1, 0, 1); PG8_STAGEB(PG8_SB(0, 0), b2);
            PG8_BAR; PG8_WAIT_L(0); PG8_MMA(0, 1, At, B1); PG8_BAR;
            PG8_LDA(At, 0, 1); PG8_STAGEA(PG8_SA(0, 0), last, 0, k2);
            PG8_BAR; PG8_WAIT_L(0); PG8_MMA(1, 0, At, B0); PG8_BAR; PG8_SCHED;
            PG8_STAGEB(PG8_SB(0, 1), b2 + hstep);
            PG8_WAIT_V(6); PG8_BAR; PG8_MMA(1, 1, At, B1); PG8_BAR;
            PG8_LDB(B0, 1, 0); PG8_SCHED; PG8_LDA(At, 1, 0); PG8_STAGEA(PG8_SA(0, 1), last, 1, k2);
            PG8_WAIT_L(8); PG8_BAR; PG8_WAIT_L(0); PG8_MMA(0, 0, At, B0); PG8_BAR; PG8_SCHED;
            PG8_LDB(B1, 1, 1); PG8_STAGEB(PG8_SB(1, 0), b3);
            PG8_BAR; PG8_WAIT_L(0); PG8_MMA(0, 1, At, B1); PG8_BAR;
            PG8_LDA(At, 1, 1); PG8_STAGEA(PG8_SA(1, 0), last, 0, k3);
            PG8_BAR; PG8_WAIT_L(0); PG8_MMA(1, 0, At, B0); PG8_BAR; PG8_SCHED;
            PG8_STAGEB(PG8_SB(1, 1), b3 + hstep);
            PG8_WAIT_V(6); PG8_BAR; PG8_MMA(1, 1, At, B1); PG8_BAR;
        }
        if constexpr (FP8) asm volatile("s_nop 15\n\ts_nop 15" ::: "memory");
        E(acc, cur, wr, wc, fr, fq);
        if (!has_next) break;
#pragma unroll
        for (int a = 0; a < 2; ++a)
#pragma unroll
            for (int b = 0; b < 2; ++b)
#pragma unroll
                for (int m = 0; m < 4; ++m)
#pragma unroll
                    for (int n = 0; n < 2; ++n) acc[a][b][m][n] = (f32x4){0.f, 0.f, 0.f, 0.f};
        cur = nxt; cA = nA; cB = nB; ++ui;
#pragma unroll
        for (int _h = 0; _h < 2; ++_h) { gvC[_h][0] = gvN[_h][0]; gvC[_h][1] = gvN[_h][1]; }
    }
    PG8_WAIT_V(0);
    if (wr == 0) PG8_BAR;
    PG8_BAR;
#undef PG8_SA
#undef PG8_SB
#undef PG8_STAGE2
#undef PG8_STAGEA
#undef PG8_STAGEB
#undef PG8_LDA
#undef PG8_LDB
#undef PG8_MMA
#undef PG8_CAT8
#undef PG8_WAIT_V
#undef PG8_WAIT_L
#undef PG8_BAR
#undef PG8_SCHED
#undef PG8_GV
}

struct EpiPlainBf16 {
    bf16_t* O; int ldc; float scale;
    DI void operator()(const f32x4 (&acc)[2][2][4][2], const Unit& u, int wr, int wc, int fr, int fq) const {
        const int odd = fr & 1; const int rowb = u.pm * BM + wr * 64 + (fr - odd), colb = u.pn * BM + wc * 64 + odd * 32 + 8 * fq;
#pragma unroll
        for (int ai = 0; ai < 2; ++ai)
#pragma unroll
            for (int m = 0; m < 4; ++m) { u32x4 X[2];
#pragma unroll
                for (int bj = 0; bj < 2; ++bj) { const f32x4 v0 = acc[ai][bj][m][0] * scale, v1 = acc[ai][bj][m][1] * scale; X[bj].x = pk2(v0[0], v0[1]); X[bj].y = pk2(v0[2], v0[3]); X[bj].z = pk2(v1[0], v1[1]); X[bj].w = pk2(v1[2], v1[3]); }
                const u32x4 recv = swap1(odd ? X[0] : X[1]);
                bf16_t* rowp = O + (size_t)(rowb + ai * HALF + m * 16) * ldc + colb;
                *(u32x4*)rowp = odd ? recv : X[0]; *(u32x4*)(rowp + ldc) = odd ? X[1] : recv; }
    }
};
constexpr float F8_SY = 16.0f;
struct EpiPlainF8 {
    unsigned char* O; int ldc; float scale;
    DI void operator()(const f32x4 (&acc)[2][2][4][2], const Unit& u, int wr, int wc, int fr, int fq) const {
        const int odd = fr & 1; const int rowb = u.pm * BM + wr * 64 + (fr - odd), colb = u.pn * BM + wc * 64 + odd * 32 + 8 * fq;
#pragma unroll
        for (int ai = 0; ai < 2; ++ai)
#pragma unroll
            for (int m = 0; m < 4; ++m) { u32x2 X[2];
#pragma unroll
                for (int bj = 0; bj < 2; ++bj) { f32x4 v0 = acc[ai][bj][m][0] * scale, v1 = acc[ai][bj][m][1] * scale;
#pragma unroll
                    for (int j = 0; j < 4; ++j) { v0[j] = f8clamp(v0[j]); v1[j] = f8clamp(v1[j]); }
                    X[bj].x = (unsigned)__builtin_amdgcn_cvt_pk_fp8_f32(v0[0], v0[1], 0, false); X[bj].x = (unsigned)__builtin_amdgcn_cvt_pk_fp8_f32(v0[2], v0[3], (int)X[bj].x, true);
                    X[bj].y = (unsigned)__builtin_amdgcn_cvt_pk_fp8_f32(v1[0], v1[1], 0, false); X[bj].y = (unsigned)__builtin_amdgcn_cvt_pk_fp8_f32(v1[2], v1[3], (int)X[bj].y, true); }
                const u32x2 recv = swap1(odd ? X[0] : X[1]);
                unsigned char* rowp = O + (size_t)(rowb + ai * HALF + m * 16) * ldc + colb;
                *(u32x2*)rowp = odd ? recv : X[0]; *(u32x2*)(rowp + ldc) = odd ? X[1] : recv; }
    }
};
struct EpiRouter {
    float* LOG;
    DI void operator()(const f32x4 (&acc)[2][2][4][2], const Unit& u, int wr, int wc, int fr, int fq) const {
        if (u.pn != 0 || wc >= 2) return;
        const int row0 = u.pm * BM + wr * 64 + fr, col0 = wc * 32 + 4 * fq;
#pragma unroll
        for (int ai = 0; ai < 2; ++ai)
#pragma unroll
            for (int m = 0; m < 4; ++m) { float* rowp = LOG + (size_t)(row0 + ai * HALF + m * 16) * 64 + col0;
#pragma unroll
                for (int n = 0; n < 2; ++n) *(f32x4*)(rowp + n * 16) = acc[ai][0][m][n]; }
    }
};
constexpr float F8_SW13 = 32.0f, F8_SH = 8.0f, F8_SW2 = 64.0f;
struct EpiSwigluF8 {
    unsigned char* H;
    DI void operator()(const f32x4 (&acc)[2][2][4][2], const Unit& u, int wr, int wc, int fr, int fq) const {
        const int row0 = u.pm * BM + wr * 64 + fr, col0 = u.pn * 128 + wc * 32 + 8 * fq;
#pragma unroll
        for (int ai = 0; ai < 2; ++ai)
#pragma unroll
            for (int m = 0; m < 4; ++m) { unsigned char* rowp = H + (size_t)(row0 + ai * HALF + m * 16) * DE + col0; float o[8];
#pragma unroll
                for (int n = 0; n < 2; ++n) { const f32x4 a = acc[ai][0][m][n], b = acc[ai][1][m][n] * (F8_SH / (F8_SW13 * F8_SW13));
#pragma unroll
                    for (int j = 0; j < 4; ++j) o[4 * n + j] = f8clamp(a[j] * b[j] * fast_rcp(1.0f + fast_exp2(a[j] * (-LOG2E / F8_SW13)))); }
                u32x2 w; w.x = (unsigned)__builtin_amdgcn_cvt_pk_fp8_f32(o[0], o[1], 0, false); w.x = (unsigned)__builtin_amdgcn_cvt_pk_fp8_f32(o[2], o[3], (int)w.x, true);
                w.y = (unsigned)__builtin_amdgcn_cvt_pk_fp8_f32(o[4], o[5], 0, false); w.y = (unsigned)__builtin_amdgcn_cvt_pk_fp8_f32(o[6], o[7], (int)w.y, true);
                *(u32x2*)(rowp) = w; }
    }
};
struct EpiInproj {
    bf16_t *U, *Gt, *Q, *Kb, *Vt, *Vtc; const LAS float* rope;
    DI void operator()(const f32x4 (&acc)[2][2][4][2], const Unit& u, int wr, int wc, int fr, int fq) const {
        const int row0 = u.pm * BM + wr * 64 + fr;
        const bool lat = u.pm < (NLAT / BM);
        if (u.pn < 4) {
            bf16_t* base = (u.pn < 2) ? U : Gt; const int odd = fr & 1; const int colb = (u.pn & 1) * 256 + wc * 64 + odd * 32 + 8 * fq;
#pragma unroll
            for (int ai = 0; ai < 2; ++ai)
#pragma unroll
                for (int m = 0; m < 4; ++m) { u32x4 X[2];
#pragma unroll
                    for (int bj = 0; bj < 2; ++bj) { const f32x4 v0 = acc[ai][bj][m][0], v1 = acc[ai][bj][m][1]; X[bj].x = pk2(v0[0], v0[1]); X[bj].y = pk2(v0[2], v0[3]); X[bj].z = pk2(v1[0], v1[1]); X[bj].w = pk2(v1[2], v1[3]); }
                    const u32x4 recv = swap1(odd ? X[0] : X[1]);
                    bf16_t* rowp = base + (size_t)(row0 - odd + ai * HALF + m * 16) * DR + colb;
                    *(u32x4*)rowp = odd ? recv : X[0]; *(u32x4*)(rowp + DR) = odd ? X[1] : recv; }
        } else {
            const bool isq = u.pn < 6;
            const int pq = ((fq & 1) << 1) | (fq >> 1), so = 8 * (fq & 1) + 16 * (fq >> 1);
#define QK_SWAP(a_, b_) asm("s_nop 1\n\tv_permlane32_swap_b32 %0, %1" : "+v"(a_), "+v"(b_))
            const float sc = isq ? 0.125f * LOG2E : 1.0f;
#pragma unroll
            for (int ai = 0; ai < 2; ++ai)
#pragma unroll
                for (int m = 0; m < 4; ++m) {
                    const int r = row0 + ai * HALF + m * 16;
                    f32x4 cs = (f32x4){1.f, 1.f, 1.f, 1.f}, sn = (f32x4){0.f, 0.f, 0.f, 0.f};
                    if (lat) { const int s = r & (SEQ - 1); const int pos = (wc & 1) ? (s & 63) : (s >> 6); cs = *(const LAS f32x4*)(rope + pos * 32 + 4 * pq); sn = *(const LAS f32x4*)(rope + pos * 32 + 16 + 4 * pq); }
                    cs = cs * sc; sn = sn * sc;
                    if (isq) {
                        bf16_t* rowp = Q + (size_t)r * 512 + (u.pn - 4) * 256 + wc * 32 + so;
#pragma unroll
                        for (int bj = 0; bj < 2; ++bj) { const f32x4 x1 = acc[ai][bj][m][0], x2 = acc[ai][bj][m][1]; const f32x4 o1 = x1 * cs - x2 * sn, o2 = x2 * cs + x1 * sn;
                            unsigned ax = pk2(o1[0], o1[1]), ay = pk2(o1[2], o1[3]), bx = pk2(o2[0], o2[1]), by = pk2(o2[2], o2[3]); QK_SWAP(ax, bx); QK_SWAP(ay, by);
                            *(u32x4*)(rowp + bj * HALF) = (u32x4){ax, ay, bx, by}; }
                    } else {
                        { bf16_t* rowp = Kb + (size_t)r * 128 + wc * 32 + so;
                          const f32x4 x1 = acc[ai][0][m][0], x2 = acc[ai][0][m][1]; const f32x4 o1 = x1 * cs - x2 * sn, o2 = x2 * cs + x1 * sn;
                          unsigned ax = pk2(o1[0], o1[1]), ay = pk2(o1[2], o1[3]), bx = pk2(o2[0], o2[1]), by = pk2(o2[2], o2[3]); QK_SWAP(ax, bx); QK_SWAP(ay, by);
                          *(u32x4*)rowp = (u32x4){ax, ay, bx, by}; }
                        const int kvh = wc >> 1; bf16_t* vb; size_t ldv;
                        const int rp = (r & ~15) | (r & 3) | ((r & 4) << 1) | ((r & 8) >> 1);
                        if (lat) { const int b = rp >> 13, s = rp & (SEQ - 1); vb = Vt + ((size_t)(b * 2 + kvh) * 64) * SEQ + s; ldv = SEQ; }
                        else { const int rc = rp - NLAT; const int b = rc >> 8, c = rc & (CL - 1); vb = Vtc + ((size_t)(b * 2 + kvh) * 64) * CL + c; ldv = CL; }
#pragma unroll
                        for (int n = 0; n < 2; ++n)
#pragma unroll
                            for (int j = 0; j < 4; ++j) { const int d = 32 * (wc & 1) + 16 * n + 4 * fq + j; vb[(size_t)d * ldv] = (bf16_t)f2bf(acc[ai][1][m][n][j]); }
                    }
                }
        }
    }
};
}

struct Params { const float* in[29]; float* out; unsigned char* ws; int ph_lo, ph_hi; };
enum { I_X = 0, I_C, I_CTX, I_CCTX, I_WMOD, I_BMOD, I_WIN, I_CONVW, I_CONVB, I_RGWA, I_RGBA, I_RGWX, I_RGBX, I_RGLAM, I_SINK, I_GNR, I_GNA, I_WOUT,
       I_LN1G, I_LN1B, I_RTG, I_RTGB, I_RTE, I_RTEB, I_W1, I_W3, I_W2, I_LN2G, I_LN2B };

typedef const __attribute__((address_space(4))) Params* PP;
DI const float* gin(PP p, int i) { return (const float*)(const GAS float*)p->in[i]; }
struct Ctx {
    LAS unsigned char* lds; int tid, lane, wave, vcu, G, bx; unsigned char* ws; float* out;
};

template <int PERM> DI void p0_transpose_item(const float* W, int K, int N, int k0, int n0, bf16_t* dst0, LAS float* scr, int lane) {
    f32x4 v[8];
#pragma unroll
    for (int i = 0; i < 8; ++i) v[i] = *(const f32x4*)(W + (size_t)(k0 + 8 * i + (lane >> 3)) * N + n0 + 4 * (lane & 7));
#pragma unroll
    for (int i = 0; i < 8; ++i) { LAS float* d = scr + (8 * i + (lane >> 3)) * 33 + 4 * (lane & 7); d[0] = v[i][0]; d[1] = v[i][1]; d[2] = v[i][2]; d[3] = v[i][3]; }
    asm volatile("s_waitcnt lgkmcnt(0)" ::: "memory");
    const int c = lane & 7;
#pragma unroll
    for (int j = 0; j < 4; ++j) { const int n = (lane >> 3) + 8 * j; const LAS float* s = scr + (8 * c) * 33 + n;
        u32x4 o; o.x = pk2(s[0 * 33], s[1 * 33]); o.y = pk2(s[2 * 33], s[3 * 33]); o.z = pk2(s[4 * 33], s[5 * 33]); o.w = pk2(s[6 * 33], s[7 * 33]);
        const int nd = (PERM == 1) ? (16 * ((n >> 2) & 1) + 4 * (n >> 3) + (n & 3)) : (PERM == 2) ? ((n & 19) | ((n & 4) << 1) | ((n & 8) >> 1)) : n;
        *(u32x4*)(dst0 + (size_t)nd * K + k0 + 8 * c) = o; }
    asm volatile("s_waitcnt lgkmcnt(0)" ::: "memory");
}

DI void p0_transpose_item_f8(const float* W, int N, int k0, int n0, unsigned char* dst0, int Kb, float sc, LAS float* scr, int lane) {
    f32x4 v[8];
#pragma unroll
    for (int i = 0; i < 8; ++i) v[i] = *(const f32x4*)(W + (size_t)(k0 + 8 * i + (lane >> 3)) * N + n0 + 4 * (lane & 7));
#pragma unroll
    for (int i = 0; i < 8; ++i) { LAS float* d = scr + (8 * i + (lane >> 3)) * 33 + 4 * (lane & 7); d[0] = v[i][0]; d[1] = v[i][1]; d[2] = v[i][2]; d[3] = v[i][3]; }
    asm volatile("s_waitcnt lgkmcnt(0)" ::: "memory");
    const int c = lane & 3;
#pragma unroll
    for (int j = 0; j < 2; ++j) { const int n = (lane >> 2) + 16 * j; const LAS float* s = scr + (16 * c) * 33 + n; u32x4 o;
#pragma unroll
        for (int q = 0; q < 4; ++q) { int w = __builtin_amdgcn_cvt_pk_fp8_f32(f8clamp(s[(4 * q) * 33] * sc), f8clamp(s[(4 * q + 1) * 33] * sc), 0, false); w = __builtin_amdgcn_cvt_pk_fp8_f32(f8clamp(s[(4 * q + 2) * 33] * sc), f8clamp(s[(4 * q + 3) * 33] * sc), w, true); o[q] = (unsigned)w; }
        const int nd = 16 * ((n >> 2) & 1) + 4 * (n >> 3) + (n & 3);
        *(u32x4*)(dst0 + (size_t)nd * Kb + k0 + 16 * c) = o; }
    asm volatile("s_waitcnt lgkmcnt(0)" ::: "memory");
}

constexpr int MOE_ITEMS = 3 * 32 * 256;
DI void moe_weight_item(const Ctx& F, PP p, int l, int r, LAS float* scr) {
    if (r < 2 * 8192) { const int which = r >> 13; r &= 8191; const int e = r >> 8, kb = (r & 255) >> 4, nb = r & 15; const int n0 = nb * 32;
        const int drow = (n0 >> 7) * 256 + which * 128 + (n0 & 127);
        p0_transpose_item_f8(gin(p, which ? I_W3 : I_W1) + ((size_t)l * NE + e) * 1024 * DE, DE, kb * 64, n0, (unsigned char*)(F.ws + WS_W13) + (((size_t)l * NE + e) * 1024 + drow) * 1024, 1024, pg8::F8_SW13, scr, F.lane); }
    else { r -= 2 * 8192; const int e = r >> 8, kb = (r & 255) >> 5, nb = r & 31;
        p0_transpose_item_f8(gin(p, I_W2) + ((size_t)l * NE + e) * DE * 1024, 1024, kb * 64, nb * 32, (unsigned char*)(F.ws + WS_W2) + (((size_t)l * NE + e) * 1024 + wblk(nb) * 32) * DE, DE, pg8::F8_SW2, scr, F.lane); }
}
DI void bg_moe_weights(const Ctx& F, PP p, int l, int budget) {
    if (l >= DEPTH) return;
    unsigned* q = (unsigned*)(F.ws + WS_CTL) + CW_BGQ + l * 64; LAS float* scr = (LAS float*)(F.lds + F.wave * 16384);
    if (budget < 0) {
        const unsigned head = (unsigned)__builtin_amdgcn_readfirstlane((int)__hip_atomic_load(q, __ATOMIC_RELAXED, __HIP_MEMORY_SCOPE_AGENT));
        for (unsigned idx = head + (unsigned)(F.vcu * 8 + F.wave); idx < (unsigned)MOE_ITEMS; idx += (unsigned)(F.G * 8)) moe_weight_item(F, p, l, (int)idx, scr);
        return; }
    unsigned idx = 0; if (F.lane == 0) idx = __hip_atomic_fetch_add(q, (unsigned)budget, __ATOMIC_RELAXED, __HIP_MEMORY_SCOPE_AGENT);
    idx = (unsigned)__builtin_amdgcn_readfirstlane((int)idx);
    for (int n = 0; n < budget && idx + (unsigned)n < (unsigned)MOE_ITEMS; ++n) moe_weight_item(F, p, l, (int)(idx + (unsigned)n), scr);
}

DI void phase_prologue_a(const Ctx& F, PP p) {
    {
        LAS float* SC = (LAS float*)F.lds;
        LAS float* RED = (LAS float*)(F.lds + 36864);
        for (int i = F.tid; i < 9 * 1024; i += 512) { const int row = i >> 10, k = i & 1023; const float v = row < 8 ? gin(p, I_C)[row * 1024 + k] : gin(p, I_CCTX)[k]; SC[i] = v * sigmoidf_(v); }
        __syncthreads();
        float* MOD = (float*)(F.ws + WS_MOD);
        for (int it = F.vcu; it < 4 * 96; it += F.G) {
            const int l = it / 96, n = (it % 96) * 64 + F.lane;
            const float* wp = gin(p, I_WMOD) + (size_t)l * 1024 * 6144 + (size_t)(F.wave * 128) * 6144 + n;
            float acc[9];
#pragma unroll
            for (int r = 0; r < 9; ++r) acc[r] = 0.f;
            for (int k0 = 0; k0 < 128; k0 += 64) {
                float wv[64];
#pragma unroll
                for (int j = 0; j < 64; ++j) wv[j] = wp[(size_t)(k0 + j) * 6144];
#pragma unroll
                for (int j = 0; j < 64; ++j)
#pragma unroll
                    for (int r = 0; r < 9; ++r) acc[r] += SC[r * 1024 + F.wave * 128 + k0 + j] * wv[j];
            }
#pragma unroll
            for (int r = 0; r < 9; ++r) RED[(F.wave * 9 + r) * 64 + F.lane] = acc[r];
            __syncthreads();
            for (int i = F.tid; i < 9 * 64; i += 512) { const int r = i >> 6, c = i & 63; float s = 0.f;
#pragma unroll
                for (int w = 0; w < 8; ++w) s += RED[(w * 9 + r) * 64 + c];
                const int nn = (it % 96) * 64 + c; MOD[((size_t)l * 9 + r) * 6144 + nn] = s + gin(p, I_BMOD)[l * 6144 + nn]; }
            __syncthreads();
        }
    }
    if (F.vcu == 0) { float* rope = (float*)(F.ws + WS_ROPE);
        for (int i = F.tid; i < 128 * 16; i += 512) { const int pos = i >> 4, j = i & 15; const float inv = exp2f(-(float)(2 * j) * (13.287712379549449f / 32.0f)); const float ang = (float)pos * inv;
            rope[pos * 32 + j] = cosf(ang); rope[pos * 32 + 16 + j] = sinf(ang); } }
    { bf16_t* WR = (bf16_t*)(F.ws + WS_WR);
      for (int i = F.vcu * 512 + F.tid; i < 4 * 256 * 1024; i += F.G * 512) { const int l = i >> 18, n = (i >> 10) & 255, k = i & 1023; float v = 0.f;
          if (n < 4) v = gin(p, I_RTG)[((size_t)l * 1024 + k) * 4 + n]; else if (n < 36) v = gin(p, I_RTE)[((size_t)l * 1024 + k) * 32 + (n - 4)];
          WR[i] = (bf16_t)f2bf(v); } }
    {
        LAS float* scr = (LAS float*)(F.lds + F.wave * 16384);
        const int gw = F.vcu * 8 + F.wave, NGW = F.G * 8;
        constexpr int I_IN = 16 * 56, I_OUT = 16 * 32, PER_L = I_IN + I_OUT;
        for (int it = gw; it < 4 * PER_L + MOE_ITEMS; it += NGW) {
            if (it >= 4 * PER_L) { moe_weight_item(F, p, 0, it - 4 * PER_L, scr); continue; }
            const int l = it / PER_L; int r = it % PER_L;
            if (r < I_IN) { const int kb = r / 56, nb = r % 56; if (nb < 32) p0_transpose_item<true>(gin(p, I_WIN) + (size_t)l * 1024 * DIN, 1024, DIN, kb * 64, nb * 32, (bf16_t*)(F.ws + WS_WIN) + ((size_t)l * DIN + wblk(nb) * 32) * 1024, scr, F.lane); else if (nb < 52) p0_transpose_item<2>(gin(p, I_WIN) + (size_t)l * 1024 * DIN, 1024, DIN, kb * 64, nb * 32, (bf16_t*)(F.ws + WS_WIN) + ((size_t)l * DIN + nb * 32) * 1024, scr, F.lane); else p0_transpose_item<0>(gin(p, I_WIN) + (size_t)l * 1024 * DIN, 1024, DIN, kb * 64, nb * 32, (bf16_t*)(F.ws + WS_WIN) + ((size_t)l * DIN + nb * 32) * 1024, scr, F.lane); continue; } r -= I_IN;
            { const int kb = r / 32, nb = r % 32; p0_transpose_item<true>(gin(p, I_WOUT) + (size_t)l * 1024 * 1024, 1024, 1024, kb * 64, nb * 32, (bf16_t*)(F.ws + WS_WOUT) + ((size_t)l * 1024 + wblk(nb) * 32) * 1024, scr, F.lane); }
        }
    }
}

DI void router_fold_weights(const Ctx& F, PP p) {
    for (int it = F.vcu * 8 + F.wave; it < 4 * 8 * 36; it += F.G * 8) {
        const int l = it / 288, b = (it / 36) % 8, n = it % 36;
        const float* mod = (const float*)(F.ws + WS_MOD) + ((size_t)l * 9 + b) * 6144; const float* sh2 = mod + 3 * D; const float* sc2 = mod + 4 * D;
        _Float16* wd = (_Float16*)(F.ws + WS_WRB) + ((size_t)(l * 8 + b) * 64 + n) * 1024;
        float sn = 0.f, tn = 0.f;
#pragma unroll 4
        for (int j = 0; j < 16; ++j) { const int k = F.lane + 64 * j;
            const float w = (n < 4) ? gin(p, I_RTG)[((size_t)l * 1024 + k) * 4 + n] : gin(p, I_RTE)[((size_t)l * 1024 + k) * 32 + (n - 4)];
            const _Float16 wf = (_Float16)((1.0f + sc2[k]) * w); wd[k] = wf; sn += (float)wf; tn = __builtin_fmaf(sh2[k], w, tn); }
        sn = wave_sum(sn); tn = wave_sum(tn);
        if (F.lane == 0) { float* SN = (float*)(F.ws + WS_SNT) + (l * 8 + b) * 64 + n; SN[0] = sn; SN[4 * 8 * 64] = tn + ((n < 4) ? gin(p, I_RTGB)[l * 4 + n] : gin(p, I_RTEB)[l * 32 + (n - 4)]); }
    }
}

DI void row_stats(const f32x4 (&v)[4], float& mean, float& rstd) {
    float s = 0.f;
#pragma unroll
    for (int j = 0; j < 4; ++j) s += (v[j][0] + v[j][1]) + (v[j][2] + v[j][3]);
    mean = wave_sum(s) * (1.f / D); float q = 0.f;
#pragma unroll
    for (int j = 0; j < 4; ++j) { const f32x4 d = v[j] - mean; q += (d[0] * d[0] + d[1] * d[1]) + (d[2] * d[2] + d[3] * d[3]); }
    rstd = 1.0f / sqrtf(wave_sum(q) * (1.f / D) + LN_EPS);
}
DI void modulate_store(const f32x4 (&v)[4], const float* sh, const float* sc, bf16_t* orow, int lane) {
    float mean, rstd; row_stats(v, mean, rstd);
#pragma unroll
    for (int j = 0; j < 4; ++j) { const int c = 4 * lane + 256 * j; const f32x4 s1 = *(const f32x4*)(sc + c), s0 = *(const f32x4*)(sh + c);
        const f32x4 h = (v[j] - mean) * rstd * (s1 + 1.0f) + s0; u32x2 w; w.x = pk2(h[0], h[1]); w.y = pk2(h[2], h[3]); *(u32x2*)(orow + c) = w; }
}
DI const float* xrow_in(PP p, const Ctx& F, int l, int r) {
    if (l == 0) return r < NLAT ? gin(p, I_X) + (size_t)r * D : gin(p, I_CTX) + (size_t)(r - NLAT) * D;
    return r < NLAT ? F.out + (size_t)r * D : (const float*)(F.ws + WS_XC) + (size_t)(r - NLAT) * D;
}
DI float* xrow_out(const Ctx& F, int r) { return r < NLAT ? F.out + (size_t)r * D : (float*)(F.ws + WS_XC) + (size_t)(r - NLAT) * D; }

template <int MODE> struct RowBuf { u32x4 x[4]; u32x2 y[4]; u32x2 z[4]; float ga, gb; u32x2 sv; f32x2 gv; };
template <int MODE> DI void rows_slot_load(u32x2& sv, f32x2& gv, const Ctx& F, int r) {
    if (MODE == 2) { sv = *(const u32x2*)((const int*)(F.ws + WS_TOKR) + 2 * (size_t)r); gv = *(const f32x2*)((const float*)(F.ws + WS_TOKG) + 2 * (size_t)r); }
}
template <int MODE, bool SRC16> DI void rows_data_load(RowBuf<MODE>& R, const Ctx& F, PP p, int l, int r, const u32x2 sv, const f32x2 gv) {
    if (SRC16) { const unsigned short* xb = (const unsigned short*)(F.ws + WS_XB) + (size_t)r * D;
#pragma unroll
        for (int j = 0; j < 4; ++j) { const u32x2 t = *(const u32x2*)(xb + 4 * F.lane + 256 * j); R.x[j] = (u32x4){t.x, t.y, 0u, 0u}; }
    } else { const float* x = (MODE == 2) ? (const float*)xrow_out(F, r) : xrow_in(p, F, MODE == 0 ? 0 : l, r);
#pragma unroll
        for (int j = 0; j < 4; ++j) R.x[j] = *(const u32x4*)(x + 4 * F.lane + 256 * j); }
    if (MODE == 1) { const bf16_t* Y = (const bf16_t*)(F.ws + WS_Y) + (size_t)r * D;
#pragma unroll
        for (int j = 0; j < 4; ++j) R.y[j] = *(const u32x2*)(Y + 4 * F.lane + 256 * j); }
    if (MODE == 2) { const unsigned char* YM = F.ws + WS_YMOE; const unsigned char* ya = YM + (size_t)sv.x * D; const unsigned char* yb = YM + (size_t)sv.y * D; R.ga = gv.x * (1.0f / pg8::F8_SY); R.gb = gv.y * (1.0f / pg8::F8_SY);
#pragma unroll
        for (int j = 0; j < 4; ++j) { R.y[j] = (u32x2){*(const unsigned*)(ya + 4 * F.lane + 256 * j), 0u}; R.z[j] = (u32x2){*(const unsigned*)(yb + 4 * F.lane + 256 * j), 0u}; } }
}
struct RowVecs { f32x4 lg[4], lb[4], gg[4], sh[4], sc[4]; };
template <int MODE, bool SRC16, bool ISCTX, bool FEED, bool LASTOUT, bool HOC> DI void row_compute(const Ctx& F, const RowBuf<MODE>& R, const RowVecs& V, const int r, const bool valid, unsigned* ctxin) {
    unsigned char* const DUM = F.ws + WS_DUMMY;
    f32x4 v[4], xv[4];
    if (SRC16) {
#pragma unroll
        for (int j = 0; j < 4; ++j) { const f32x2 a = unpkh2(R.x[j].x), b2 = unpkh2(R.x[j].y); xv[j] = (f32x4){a.x, a.y, b2.x, b2.y}; }
    } else {
#pragma unroll
        for (int j = 0; j < 4; ++j) xv[j] = __builtin_bit_cast(f32x4, R.x[j]);
    }
    if (MODE == 0) {
#pragma unroll
        for (int j = 0; j < 4; ++j) v[j] = xv[j];
    } else {
#pragma unroll
        for (int j = 0; j < 4; ++j) { f32x4 yv;
            if (MODE == 2) { const f32x2 a0 = __builtin_amdgcn_cvt_pk_f32_fp8((int)R.y[j].x, false), a1 = __builtin_amdgcn_cvt_pk_f32_fp8((int)R.y[j].x, true), b0 = __builtin_amdgcn_cvt_pk_f32_fp8((int)R.z[j].x, false), b1 = __builtin_amdgcn_cvt_pk_f32_fp8((int)R.z[j].x, true);
                yv = (f32x4){a0.x, a0.y, a1.x, a1.y} * R.ga + (f32x4){b0.x, b0.y, b1.x, b1.y} * R.gb; }
            else yv = (f32x4){bf_lo(R.y[j].x), bf_hi(R.y[j].x), bf_lo(R.y[j].y), bf_hi(R.y[j].y)};
            v[j] = xv[j] * ALPHA + V.gg[j] * yv; }
        float mean, rstd; row_stats(v, mean, rstd);
#pragma unroll
        for (int j = 0; j < 4; ++j) v[j] = (v[j] - mean) * rstd * V.lg[j] + V.lb[j];
        if (!ISCTX && !LASTOUT) { unsigned short* xb = valid ? (unsigned short*)(F.ws + WS_XB) + (size_t)r * D : (unsigned short*)DUM;
#pragma unroll
            for (int j = 0; j < 4; ++j) { u32x2 w; w.x = pkh2(v[j][0], v[j][1]); w.y = pkh2(v[j][2], v[j][3]); *(u32x2*)(xb + 4 * F.lane + 256 * j) = w; }
        } else { float* xo = valid ? xrow_out(F, r) : (float*)DUM;
#pragma unroll
            for (int j = 0; j < 4; ++j) *(f32x4*)(xo + 4 * F.lane + 256 * j) = v[j]; }
    }
    if (FEED) { float mean, rstd; row_stats(v, mean, rstd);
        if (MODE == 1 && !ISCTX) { float* st = (valid && F.lane == 0) ? (float*)(F.ws + WS_ROWST) + 2 * (size_t)r : (float*)DUM + 2 * F.lane; *(f32x2*)st = (f32x2){mean, rstd}; }
        bf16_t* orow = valid ? (bf16_t*)(F.ws + WS_HA) + (size_t)r * D : (bf16_t*)DUM; unsigned char* o8 = valid ? F.ws + WS_HA8 + (size_t)r * D : DUM;
#pragma unroll
        for (int j = 0; j < 4; ++j) { const f32x4 hh = (v[j] - mean) * rstd * (V.sc[j] + 1.0f) + V.sh[j]; u32x2 w; w.x = pk2(hh[0], hh[1]); w.y = pk2(hh[2], hh[3]);
            if (HOC) __hip_atomic_store((unsigned long long*)(orow + 4 * F.lane + 256 * j), ((unsigned long long)w.y << 32) | w.x, __ATOMIC_RELAXED, __HIP_MEMORY_SCOPE_AGENT);
            else if (MODE != 1 || ISCTX) *(u32x2*)(orow + 4 * F.lane + 256 * j) = w;
            if (MODE == 1) { int q = __builtin_amdgcn_cvt_pk_fp8_f32(f8clamp(hh[0]), f8clamp(hh[1]), 0, false); q = __builtin_amdgcn_cvt_pk_fp8_f32(f8clamp(hh[2]), f8clamp(hh[3]), q, true); *(unsigned*)(o8 + 4 * F.lane + 256 * j) = (unsigned)q; } } }
    if (HOC) { asm volatile("s_waitcnt vmcnt(0)" ::: "memory"); if (F.lane == 0) __hip_atomic_fetch_add(ctxin + ((r - NLAT) >> 8) * 64, 1u, __ATOMIC_RELAXED, __HIP_MEMORY_SCOPE_AGENT); }
}
template <int MODE, bool FEED> DI void rows_load_vecs(RowVecs& V, const Ctx& F, int l, int b) {
    const float* mod = (const float*)(F.ws + WS_MOD) + (size_t)(MODE == 0 ? 0 : l) * 9 * 6144 + (size_t)b * 6144;
    const float* pg = mod + (MODE == 1 ? 2 * D : 5 * D); const float* psh = (MODE == 0) ? mod : (MODE == 1 ? mod + 3 * D : mod + 9 * 6144); const float* psc = (MODE == 0) ? mod + D : (MODE == 1 ? mod + 4 * D : mod + 9 * 6144 + D);
#pragma unroll
    for (int j = 0; j < 4; ++j) { const int c = 4 * F.lane + 256 * j; if (MODE != 0) V.gg[j] = *(const f32x4*)(pg + c);
        if (FEED) { V.sh[j] = *(const f32x4*)(psh + c); V.sc[j] = *(const f32x4*)(psc + c); } }
}
template <int MODE, bool SRC16, bool FEED, bool LASTOUT> DI void rows_run(const Ctx& F, PP p, int l, const int rbase, const int n, RowVecs& V) {
    rows_load_vecs<MODE, FEED>(V, F, l, rbase >> 13);
#define ROW_C(k) (rbase + 8 * ((k) < n ? (k) : n - 1))
    RowBuf<MODE> r0, r1, r2;
    r0.sv = r1.sv = r2.sv = (u32x2){0u, 0u}; r0.gv = r1.gv = r2.gv = (f32x2){0.f, 0.f};
    rows_slot_load<MODE>(r0.sv, r0.gv, F, ROW_C(0)); rows_slot_load<MODE>(r1.sv, r1.gv, F, ROW_C(1)); rows_slot_load<MODE>(r2.sv, r2.gv, F, ROW_C(2));
    rows_data_load<MODE, SRC16>(r0, F, p, l, ROW_C(0), r0.sv, r0.gv); rows_data_load<MODE, SRC16>(r1, F, p, l, ROW_C(1), r1.sv, r1.gv);
    auto step = [&](RowBuf<MODE>& cur, RowBuf<MODE>& ld, const int k) __attribute__((always_inline)) {
        rows_slot_load<MODE>(cur.sv, cur.gv, F, ROW_C(k + 3));
        rows_data_load<MODE, SRC16>(ld, F, p, l, ROW_C(k + 2), ld.sv, ld.gv);
        row_compute<MODE, SRC16, false, FEED, LASTOUT, false>(F, cur, V, ROW_C(k), k < n, nullptr);
    };
    step(r0, r2, 0); step(r1, r0, 1); step(r2, r1, 2);
    for (int k = 3; k < n; k += 3) { step(r0, r2, k); step(r1, r0, k + 1); step(r2, r1, k + 2); }
#undef ROW_C
}
template <int MODE, bool HANDOFF> DI void phase_rows(const Ctx& F, PP p, int l, int nrows) {
    constexpr bool FEED = (MODE != 2) || HANDOFF, LASTOUT = (MODE == 2) && !HANDOFF;
    const int gw = F.vcu * 8 + F.wave, NGW = F.G * 8;
    constexpr int PU = (MODE == 0) ? 22 : 26, PO = (MODE == 0) ? 35 : 34;
    static_assert(448 * PU + 1600 * PO >= NLAT, "row split");
    const bool ho = HANDOFF && F.G == 256;
    const int per = ho ? (F.vcu < 56 ? PU : PO) : (NLAT + NGW - 1) / NGW;
    const int lstart = (ho ? (F.vcu < 56 ? F.vcu * 8 * PU : 448 * PU + (F.vcu - 56) * 8 * PO) : F.vcu * 8 * per) + F.wave;
    const int nctx = (nrows > NLAT) ? (nrows - NLAT + NGW - 1) / NGW : 0;
    int nlat = (NLAT - lstart + 7) / 8; nlat = nlat < 0 ? 0 : (nlat > per ? per : nlat);
    unsigned* ctxin = (unsigned*)(F.ws + WS_CTL) + CW_CTXIN + (MODE == 0 ? 0 : l + 1) * 8 * 64;
    RowVecs V;
    if (MODE != 0) { const float* g = gin(p, MODE == 1 ? I_LN1G : I_LN2G) + l * D; const float* bb = gin(p, MODE == 1 ? I_LN1B : I_LN2B) + l * D;
#pragma unroll
        for (int j = 0; j < 4; ++j) { V.lg[j] = *(const f32x4*)(g + 4 * F.lane + 256 * j); V.lb[j] = *(const f32x4*)(bb + 4 * F.lane + 256 * j); } }
    auto ctx_rows = [&]() __attribute__((always_inline)) {
        for (int k = 0; k < nctx; ++k) { const int r = NLAT + gw + k * NGW; if (r >= nrows) break;
            rows_load_vecs<MODE, FEED>(V, F, l, 8);
            RowBuf<MODE> rb; u32x2 sv = (u32x2){0u, 0u}; f32x2 gv = (f32x2){0.f, 0.f}; rows_slot_load<MODE>(sv, gv, F, r); rows_data_load<MODE, false>(rb, F, p, l, r, sv, gv);
            if (ho) row_compute<MODE, false, true, FEED, LASTOUT, HANDOFF>(F, rb, V, r, true, ctxin); else row_compute<MODE, false, true, FEED, LASTOUT, false>(F, rb, V, r, true, ctxin); } };
    if (ho) ctx_rows();
    for (int k0 = 0; k0 < nlat; ) {
        const int rbase = lstart + 8 * k0; const int rend = ((rbase >> 13) + 1) << 13; int n = (rend - rbase + 7) / 8; n = n < nlat - k0 ? n : nlat - k0;
        if (MODE == 2) rows_run<MODE, true, FEED, LASTOUT>(F, p, l, rbase, n, V);
        else if (MODE == 1 && l > 0) rows_run<MODE, MODE == 1, FEED, LASTOUT>(F, p, l, rbase, n, V);
        else rows_run<MODE, false, FEED, LASTOUT>(F, p, l, rbase, n, V);
        k0 += n; }
    if (!ho) ctx_rows();
    if (ho && nctx > 0 && F.vcu < 56) {
        const int tile = F.vcu / 7, pn = F.vcu % 7, ln = (MODE == 0) ? 0 : l + 1;
        __syncthreads();
        if (F.wave == 0) { unsigned* cw = ctxin + tile * 64; unsigned spins = 0;
            while ((unsigned)__builtin_amdgcn_readfirstlane(__hip_atomic_load(cw, __ATOMIC_RELAXED, __HIP_MEMORY_SCOPE_AGENT)) < 256u) { __builtin_amdgcn_s_sleep(4); if (++spins > (1u << 22)) break; }
            __builtin_amdgcn_fence(__ATOMIC_ACQUIRE, "agent"); asm volatile("s_waitcnt vmcnt(0)" ::: "memory"); }
        __syncthreads();
        pg8::OneUnit S; S.pm = NLAT / 256 + tile; S.pn = pn; S.K = 1024;
        pg8::EpiInproj E{(bf16_t*)(F.ws + WS_U), (bf16_t*)(F.ws + WS_G), (bf16_t*)(F.ws + WS_Q), (bf16_t*)(F.ws + WS_KB), (bf16_t*)(F.ws + WS_VT), (bf16_t*)(F.ws + WS_VTC), (const LAS float*)(F.lds + ROPE_OFF)};
        pg8::gemm_phase<pg8::EpiInproj, pg8::OneUnit>(F.lds, F.tid, (const bf16_t*)(F.ws + WS_HA), (const bf16_t*)(F.ws + WS_WIN) + (size_t)ln * DIN * 1024, 1024, S, E);
    }
}
DI void phase_scan(const Ctx& F, PP p, int l) {
    constexpr int XC_OFF = 0, AGG_OFF = 36864, CARRY_OFF = 36864 + 8192;
    const bf16_t* U = (const bf16_t*)(F.ws + WS_U); bf16_t* XV = (bf16_t*)(F.ws + WS_XCV);
    unsigned* cnt = (unsigned*)(F.ws + WS_CTL) + CW_SCANX + l * 64 * 64;
    for (int it = F.vcu; it < 256; it += F.G) {
        const int b = it >> 5, cb = (it >> 2) & 7, qd = it & 3;
        const int ck = F.lane & 7, rsub = F.lane >> 3;
        float w[4][8], bias[8];
#pragma unroll
        for (int j = 0; j < 4; ++j) { const f32x4 wa = *(const f32x4*)(gin(p, I_CONVW) + (l * 4 + j) * DR + cb * 64 + ck * 8), wb = *(const f32x4*)(gin(p, I_CONVW) + (l * 4 + j) * DR + cb * 64 + ck * 8 + 4);
            w[j][0] = wa[0]; w[j][1] = wa[1]; w[j][2] = wa[2]; w[j][3] = wa[3]; w[j][4] = wb[0]; w[j][5] = wb[1]; w[j][6] = wb[2]; w[j][7] = wb[3]; }
        { const f32x4 ba = *(const f32x4*)(gin(p, I_CONVB) + l * DR + cb * 64 + ck * 8), bb = *(const f32x4*)(gin(p, I_CONVB) + l * DR + cb * 64 + ck * 8 + 4);
          bias[0] = ba[0]; bias[1] = ba[1]; bias[2] = ba[2]; bias[3] = ba[3]; bias[4] = bb[0]; bias[5] = bb[1]; bias[6] = bb[2]; bias[7] = bb[3]; }
#define CONV_GEOM(blk_) const int idx0 = 2112 * qd + 32 * (blk_) + 4 * rsub; const bool isctx = idx0 < CL; const int L = isctx ? CL : SEQ; const int pos0 = isctx ? idx0 : idx0 - CL; const int rowbase = isctx ? NLAT + b * CL : b * SEQ;
#define CONV_LOAD(dst, blk_) do { CONV_GEOM(blk_); _Pragma("unroll") for (int k = 0; k < 7; ++k) { int pos = pos0 - 2 + k; const bool ok = pos >= 0 && pos < L; pos = ok ? pos : pos0; \
            const u32x4 t = *(const u32x4*)(U + (size_t)(rowbase + pos) * DR + cb * 64 + ck * 8); dst[k] = ok ? t : (u32x4){0u, 0u, 0u, 0u}; } } while (0)
#define CONV_DO(src, blk_) do { CONV_GEOM(blk_); _Pragma("unroll") for (int i = 0; i < 4; ++i) { float x[8]; \
            _Pragma("unroll") for (int e = 0; e < 8; ++e) x[e] = bias[e]; \
            _Pragma("unroll") for (int j = 0; j < 4; ++j) _Pragma("unroll") for (int e = 0; e < 4; ++e) { x[2 * e] = __builtin_fmaf(w[j][2 * e], bf_lo(src[i + j][e]), x[2 * e]); x[2 * e + 1] = __builtin_fmaf(w[j][2 * e + 1], bf_hi(src[i + j][e]), x[2 * e + 1]); } \
            u32x4 o; o.x = pk2(x[0], x[1]); o.y = pk2(x[2], x[3]); o.z = pk2(x[4], x[5]); o.w = pk2(x[6], x[7]); \
            *(u32x4*)(XV + (size_t)(rowbase + pos0 + i) * DR + cb * 64 + ck * 8) = o; } } while (0)
        u32x4 ua[7], ub[7];
        CONV_LOAD(ua, F.wave);
        for (int blk = F.wave; blk < 66; blk += 16) {
            { const int bn = blk + 8 < 66 ? blk + 8 : blk; CONV_LOAD(ub, bn); }
            CONV_DO(ua, blk);
            { const int bn = blk + 16 < 66 ? blk + 16 : blk; CONV_LOAD(ua, bn); }
            if (blk + 8 < 66) CONV_DO(ub, blk + 8);
        }
#undef CONV_DO
#undef CONV_GEOM
#undef CONV_LOAD
    }
    asm volatile("s_waitcnt vmcnt(0)" ::: "memory"); __syncthreads();
    if (F.tid == 0) { __builtin_amdgcn_fence(__ATOMIC_RELEASE, "agent");
        for (int it = F.vcu; it < 256; it += F.G) __hip_atomic_fetch_add(cnt + (it >> 2) * 64, 1u, __ATOMIC_RELAXED, __HIP_MEMORY_SCOPE_AGENT); }
    const int c = F.lane & 31, h = F.lane >> 5, hw = 2 * F.wave + h;
    for (int it = F.vcu; it < 256; it += F.G) {
        const int b = it >> 5, cb = (it >> 2) & 7, dir = (it >> 1) & 1, half = it & 1;
        const int oc = cb * 64 + 32 * half + c;
        bf16_t* OUT = (bf16_t*)(F.ws + (dir ? WS_HB : WS_HF));
        if (F.wave == 0) { unsigned* cw = cnt + (it >> 2) * 64; unsigned spins = 0;
            while ((unsigned)__builtin_amdgcn_readfirstlane(__hip_atomic_load(cw, __ATOMIC_RELAXED, __HIP_MEMORY_SCOPE_AGENT)) < 4u) { __builtin_amdgcn_s_sleep(2); if (++spins > (1u << 22)) break; }
            __builtin_amdgcn_fence(__ATOMIC_ACQUIRE, "agent"); }
        __syncthreads();
        bf16x8 Bwa[4], Bwx[4];
        { const float* wa = gin(p, I_RGWA) + ((size_t)((l * 2 + dir) * 8 + cb) * 64) * 64 + 32 * half + c;
          const float* wx = gin(p, I_RGWX) + ((size_t)((l * 2 + dir) * 8 + cb) * 64) * 64 + 32 * half + c;
#pragma unroll
          for (int s = 0; s < 4; ++s) { u32x4 a, x;
#pragma unroll
              for (int j = 0; j < 4; ++j) { const int i0 = 16 * s + 8 * h + 2 * j; a[j] = pk2(-LOG2E * wa[(size_t)i0 * 64], -LOG2E * wa[(size_t)(i0 + 1) * 64]); x[j] = pk2(-LOG2E * wx[(size_t)i0 * 64], -LOG2E * wx[(size_t)(i0 + 1) * 64]); }
              Bwa[s] = __builtin_bit_cast(bf16x8, a); Bwx[s] = __builtin_bit_cast(bf16x8, x); } }
        const float ba = -LOG2E * gin(p, I_RGBA)[(l * 2 + dir) * DR + oc], bx = -LOG2E * gin(p, I_RGBX)[(l * 2 + dir) * DR + oc];
        float c8;
        { const float lam = gin(p, I_RGLAM)[(l * 2 + dir) * DR + oc]; const float e = __expf(-lam);
          const float sp = (e < 0.03f) ? e * (1.0f - e * (0.5f - e * (0.33333333f - 0.25f * e))) : __logf(1.0f + e); c8 = -8.0f * sp; }
        const float c8l = c8 * LOG2E;
        LAS unsigned char* XCw = F.lds + XC_OFF + F.wave * 4608;
        LAS float* CARRY = (LAS float*)(F.lds + CARRY_OFF);
        const int tokr = 16 * ((c >> 2) & 1) + (c & 3) + 4 * (c >> 3);
        u32x4 pre[4];
#define SCAN_GEOM(sc_) const bool isctx_ = ((sc_) == 0); const int L_ = isctx_ ? CL : SEQ; const int tau0_ = isctx_ ? 0 : 256 * ((sc_) - 1); \
        const int plo_ = dir ? L_ - tau0_ - 256 : tau0_; const int rowbase_ = isctx_ ? NLAT + b * CL : b * SEQ;
#define SCAN_LOAD(sc_) do { SCAN_GEOM(sc_); _Pragma("unroll") for (int k = 0; k < 4; ++k) { const int q = F.lane + 64 * k, j = q >> 3, ck = q & 7; const int st = 32 * F.wave + j; \
            const int pos = dir ? plo_ + 255 - st : plo_ + st; pre[k] = *(const u32x4*)(XV + (size_t)(rowbase_ + pos) * DR + cb * 64 + ck * 8); } } while (0)
        SCAN_LOAD(0);
        for (int sc = 0; sc < 33; ++sc) {
            SCAN_GEOM(sc); const int p_lo = plo_, rowbase = rowbase_;
            LAS f32x2* AGG = (LAS f32x2*)(F.lds + AGG_OFF + (sc & 1) * 4096);
#pragma unroll
            for (int k = 0; k < 4; ++k) { const int q = F.lane + 64 * k; *(LAS u32x4*)(XCw + (q >> 3) * 144 + (q & 7) * 16) = pre[k]; }
            if (sc + 1 < 33) SCAN_LOAD(sc + 1);
            asm volatile("s_waitcnt lgkmcnt(0)" ::: "memory");
            float xo[16];
#pragma unroll
            for (int i = 0; i < 16; ++i) xo[i] = bf2f(*(const LAS bf16_t*)(XCw + (16 * h + i) * 144 + 2 * (32 * half + c)));
            f32x16 Da, Dx;
#pragma unroll
            for (int i = 0; i < 16; ++i) { Da[i] = ba; Dx[i] = bx; }
#pragma unroll
            for (int s = 0; s < 4; ++s) { const bf16x8 Af = *(const LAS bf16x8*)(XCw + tokr * 144 + 32 * s + 16 * h);
                Da = __builtin_amdgcn_mfma_f32_32x32x16_bf16(Af, Bwa[s], Da, 0, 0, 0); Dx = __builtin_amdgcn_mfma_f32_32x32x16_bf16(Af, Bwx[s], Dx, 0, 0, 0); }
            float H[16], PP[16]; float hloc = 0.f, P = 1.f;
#pragma unroll
            for (int i = 0; i < 16; ++i) {
                const float r = fast_rcp(1.0f + fast_exp2(Da[i])), gi = fast_rcp(1.0f + fast_exp2(Dx[i]));
                const float a = fast_exp2(c8l * r);
                const float om = __builtin_fmaf(-a, a, 1.0f);
                const float bb = __builtin_amdgcn_sqrtf(om) * gi * xo[i];
                hloc = __builtin_fmaf(a, hloc, bb); P *= a; H[i] = hloc; PP[i] = P; }
            AGG[hw * 32 + c] = (f32x2){P, hloc};
            lds_barrier();
            float cin = CARRY[(sc & 1) * 32 + c]; f32x2 agv[15];
#pragma unroll
            for (int k = 0; k < 15; ++k) agv[k] = AGG[k * 32 + c];
            __builtin_amdgcn_sched_barrier(0);
            cin = (sc == 0) ? 0.f : cin;
#pragma unroll
            for (int k = 0; k < 15; ++k) { const float nc = agv[k].x * cin + agv[k].y; cin = (k < hw) ? nc : cin; }
            if (hw == 15) CARRY[((sc + 1) & 1) * 32 + c] = P * cin + hloc;
#pragma unroll
            for (int i = 0; i < 16; i += 2) { const float hv0 = __builtin_fmaf(PP[i], cin, H[i]), hv1 = __builtin_fmaf(PP[i + 1], cin, H[i + 1]);
                const unsigned pk = dir ? pk2(hv1, hv0) : pk2(hv0, hv1);
                const int pe = dir ? p_lo + 254 - (16 * hw + i) : p_lo + 16 * hw + i;
                unsigned* ob = (unsigned*)OUT + ((size_t)(cb * 2 + half) * (NT / 2) + (size_t)(rowbase >> 1)) * 32;
                ob[(unsigned)((pe >> 1) * 32 + c)] = pk; }
        }
#undef SCAN_GEOM
#undef SCAN_LOAD
        __syncthreads();
    }
}

DI int crow16(int i, int h) { return (i & 3) + 8 * (i >> 2) + 4 * h; }
DI bf16x8 pack8(const f32x16& x, int s) { u32x4 q; q.x = pk2(x[8 * s], x[8 * s + 1]); q.y = pk2(x[8 * s + 2], x[8 * s + 3]); q.z = pk2(x[8 * s + 4], x[8 * s + 5]); q.w = pk2(x[8 * s + 6], x[8 * s + 7]); return __builtin_bit_cast(bf16x8, q); }
#define ATT_DEAD(qb, kb) ((MM == 1 && (qb) == 1 && (kb) == 0) || (MM == 2 && (qb) == 0 && (kb) == 1))
constexpr float ATT_THR = 6.0f;
template <int MM, int QB> DI void att_st(f32x16 (&St)[2], const LAS unsigned char* Kl, const bf16x8 (&Qf)[2][4], const float (&mrun)[2], const int c, const int h) {
    const float m0 = -mrun[QB];
#pragma unroll
    for (int kb = 0; kb < 2; ++kb)
#pragma unroll
        for (int i = 0; i < 16; ++i) St[kb][i] = m0;
    constexpr int NKB = (ATT_DEAD(QB, 0) ? 0 : 1) + (ATT_DEAD(QB, 1) ? 0 : 1), KB0 = ATT_DEAD(QB, 0) ? 1 : 0, NF = 4 * NKB;
#define ATT_KF(i_) (*(const LAS bf16x8*)(Kl + (32 * (NKB == 2 ? ((i_) & 1) : KB0) + c) * 144 + 32 * (NKB == 2 ? ((i_) >> 1) : (i_)) + 16 * h))
    bf16x8 Kw[3]; Kw[0] = ATT_KF(0); Kw[1] = ATT_KF(1);
#pragma unroll
    for (int i = 0; i < NF; ++i) { const int kb = (NKB == 2) ? (i & 1) : KB0, s = (NKB == 2) ? (i >> 1) : i;
        if (i + 2 < NF) Kw[(i + 2) % 3] = ATT_KF(i + 2);
        St[kb] = __builtin_amdgcn_mfma_f32_32x32x16_bf16(Kw[i % 3], Qf[QB][s], St[kb], 0, 0, 0); }
    if (QB == 0 && NF >= 2) {
        __builtin_amdgcn_sched_group_barrier(0x100, 2, 0);
#pragma unroll
        for (int i = 0; i < NF - 2; ++i) { __builtin_amdgcn_sched_group_barrier(0x008, 1, 0); __builtin_amdgcn_sched_group_barrier(0x100, 1, 0); }
        __builtin_amdgcn_sched_group_barrier(0x008, 2, 0); }
#undef ATT_KF
}
template <int MM, int QB> DI void att_softmax(f32x16 (&St)[2], bf16x8 (&Pf)[2][2], f32x16 (&O)[2][2], float (&mrun)[2], float (&lsum)[2], const int c, const int h) {
    if (MM != 0) {
#pragma unroll
        for (int kb = 0; kb < 2; ++kb) {
            if (ATT_DEAD(QB, kb)) {
#pragma unroll
                for (int i = 0; i < 16; ++i) St[kb][i] = -1.0e30f;
            } else if (kb == QB) {
#pragma unroll
                for (int i = 0; i < 16; ++i) { const int kr = crow16(i, h); const bool bad = (MM == 1) ? (c > kr) : (kr > c); St[kb][i] = bad ? -1.0e30f : St[kb][i]; }
            } }
    }
    float tmax = -3.0e38f;
#pragma unroll
    for (int kb = 0; kb < 2; ++kb)
#pragma unroll
        for (int i = 0; i < 16; ++i) tmax = fmaxf(tmax, St[kb][i]);
    tmax = xor32_max(tmax);
    if (__builtin_amdgcn_ballot_w64(tmax > ATT_THR) != 0ull) {
        const float d = fmaxf(tmax, 0.f); const float alpha = fast_exp2(-d); mrun[QB] += d; lsum[QB] *= alpha;
#pragma unroll
        for (int kb = 0; kb < 2; ++kb)
#pragma unroll
            for (int i = 0; i < 16; ++i) St[kb][i] -= d;
#pragma unroll
        for (int db = 0; db < 2; ++db)
#pragma unroll
            for (int i = 0; i < 16; ++i) O[db][QB][i] *= alpha;
    }
    float ps = 0.f;
#pragma unroll
    for (int kb = 0; kb < 2; ++kb) {
#pragma unroll
        for (int i = 0; i < 16; ++i) { const float pv = fast_exp2(St[kb][i]); St[kb][i] = pv; ps += pv; }
        Pf[kb][0] = pack8(St[kb], 0); Pf[kb][1] = pack8(St[kb], 1); }
    lsum[QB] += ps;
}
template <int MM, int QB> DI void att_pv(const bf16x8 (&Pf)[2][2], f32x16 (&O)[2][2], const LAS unsigned char* Vl, const int c, const int h) {
    constexpr int NKB = (ATT_DEAD(QB, 0) ? 0 : 1) + (ATT_DEAD(QB, 1) ? 0 : 1), KB0 = ATT_DEAD(QB, 0) ? 1 : 0, NF = 4 * NKB;
#define ATT_VF(i_) (*(const LAS bf16x8*)(Vl + (32 * ((i_) & 1) + c) * 144 + (32 * (NKB == 2 ? ((i_) >> 2) : KB0) + 16 * (((i_) >> 1) & 1) + 8 * h) * 2))
    bf16x8 Vw[3]; Vw[0] = ATT_VF(0); Vw[1] = ATT_VF(1);
#pragma unroll
    for (int i = 0; i < NF; ++i) { const int db = i & 1, s2 = (i >> 1) & 1, kb = (NKB == 2) ? (i >> 2) : KB0;
        if (i + 2 < NF) Vw[(i + 2) % 3] = ATT_VF(i + 2);
        O[db][QB] = __builtin_amdgcn_mfma_f32_32x32x16_bf16(Vw[i % 3], Pf[kb][s2], O[db][QB], 0, 0, 0); }
    if (QB == 1 && NF >= 2) {
        __builtin_amdgcn_sched_group_barrier(0x100, 2, 0);
#pragma unroll
        for (int i = 0; i < NF - 2; ++i) { __builtin_amdgcn_sched_group_barrier(0x008, 1, 0); __builtin_amdgcn_sched_group_barrier(0x100, 1, 0); }
        __builtin_amdgcn_sched_group_barrier(0x008, 2, 0); }
#undef ATT_VF
}
template <int MM> DI void att_tile(const LAS unsigned char* Kl, const LAS unsigned char* Vl, const bf16x8 (&Qf)[2][4], f32x16 (&O)[2][2], float (&mrun)[2], float (&lsum)[2], const int c, const int h) {
    f32x16 St0[2], St1[2]; bf16x8 Pf0[2][2], Pf1[2][2];
    __builtin_amdgcn_sched_barrier(0);
    att_st<MM, 0>(St0, Kl, Qf, mrun, c, h);
    __builtin_amdgcn_sched_barrier(0);
    att_st<MM, 1>(St1, Kl, Qf, mrun, c, h);
    att_softmax<MM, 0>(St0, Pf0, O, mrun, lsum, c, h);
    __builtin_amdgcn_sched_barrier(0);
    att_pv<MM, 0>(Pf0, O, Vl, c, h);
    att_softmax<MM, 1>(St1, Pf1, O, mrun, lsum, c, h);
    __builtin_amdgcn_sched_barrier(0);
    att_pv<MM, 1>(Pf1, O, Vl, c, h);
    __builtin_amdgcn_sched_barrier(0);
}
#undef ATT_DEAD
DI void phase_attn(const Ctx& F, PP p, int l) {
    constexpr int STG = 36864, V_OFF = 18432, SS_OFF = 3 * 36864;
    const bf16_t* Q = (const bf16_t*)(F.ws + WS_Q); const bf16_t* Kb = (const bf16_t*)(F.ws + WS_KB); const bf16_t* Vt = (const bf16_t*)(F.ws + WS_VT); const bf16_t* Vtc = (const bf16_t*)(F.ws + WS_VTC);
    const bf16_t* HF = (const bf16_t*)(F.ws + WS_HF); const bf16_t* HB = (const bf16_t*)(F.ws + WS_HB); const bf16_t* Gt = (const bf16_t*)(F.ws + WS_G); bf16_t* HA = (bf16_t*)(F.ws + WS_HA);
    const int nitems = 1024 + ((l < DEPTH - 1) ? 32 : 0);
    const int head = F.wave, kvh = F.wave >> 2;
    const float* gna = gin(p, I_GNA) + l * 512 + head * 64; const float* gnr = gin(p, I_GNR) + l * 512;
    LAS float* SS = (LAS float*)(F.lds + SS_OFF);
    unsigned* ctxcnt = (unsigned*)(F.ws + WS_CTL) + CW_CTXMIX + l * 8 * 64;
    const bool hasctx = nitems > 1024;
    for (int k2 = 0; k2 < 10; ++k2) {
        const bool do_attn = (((k2 ^ F.vcu) & 1) == 0);
        int it;
        if ((k2 >> 1) == 0) { const int v = F.vcu; if (!hasctx) continue; if (do_attn) { if (v >= 32) continue; it = 1024 + v; } else { if (v < 32 || v >= 64) continue; it = 1024 + (v - 32); } }
        else { it = F.vcu + ((k2 >> 1) - 1) * F.G; if (it >= 1024) continue; }
      if (do_attn) {
        const int ti = F.wave * 64 + lane_id_v();
        const int lane_i = ti & 63, c = ti & 31, h = (ti >> 5) & 1;
        const bool islat = it < 1024; int b, q0 = 0, rowbase, kk_lo = 0, nb = 0;
        if (islat) { b = it >> 7; q0 = (it & 127) * 64; rowbase = b * SEQ + q0; kk_lo = -(q0 >> 6); if (kk_lo < -2) kk_lo = -2; int kk_hi = (SEQ - 64 - q0) >> 6; if (kk_hi > 2) kk_hi = 2; nb = kk_hi - kk_lo + 1; }
        else { const int ci = it - 1024; b = ci >> 2; rowbase = NLAT + b * CL + (ci & 3) * 64; }
        const int ntile = nb + 4;
        bf16x8 Qf[2][4];
#pragma unroll
        for (int qb = 0; qb < 2; ++qb)
#pragma unroll
            for (int s = 0; s < 4; ++s) Qf[qb][s] = *(const bf16x8*)(Q + (size_t)(rowbase + 32 * qb + c) * 512 + head * 64 + 16 * s + 8 * h);
        const float sink2 = gin(p, I_SINK)[l * 8 + head] * LOG2E;
        float mrun[2] = {sink2, sink2}, lsum[2]; lsum[0] = lsum[1] = (h == 0) ? 1.0f : 0.0f;
        asm volatile("" ::: "memory");
        f32x16 O[2][2];
#pragma unroll
        for (int db = 0; db < 2; ++db)
#pragma unroll
            for (int qb = 0; qb < 2; ++qb)
#pragma unroll
                for (int i = 0; i < 16; ++i) O[db][qb][i] = 0.f;
#define ATT_SRC(j, krow0, vbase, ldv, mode) int krow0; const bf16_t* vbase; int ldv; int mode = 0; \
        if ((j) < nb) { const int kk = kk_lo + (j); const int k0 = q0 + 64 * kk; krow0 = b * SEQ + k0; vbase = Vt + (size_t)(b * 128) * SEQ + k0; ldv = SEQ; mode = (kk == -2) ? 1 : ((kk == 2) ? 2 : 0); } \
        else { const int cx = (j) - nb; krow0 = NLAT + b * CL + 64 * cx; vbase = Vtc + (size_t)(b * 128) * CL + 64 * cx; ldv = CL; }
#define ATT_DMA(buf, krow0, vbase, ldv) do { int ln_ = lane_i; asm volatile("" : "+v"(ln_)); _Pragma("unroll") for (int t_ = 0; t_ < 5; ++t_) { const int in_ = F.wave + 8 * t_; if (in_ < 36) { const bf16_t* g_; \
            if (in_ < 18) { const int q_ = in_ * 64 + ln_; const int kvh_ = q_ / 576, rem_ = q_ - kvh_ * 576, key_ = rem_ / 9, col_ = rem_ - key_ * 9; g_ = Kb + (size_t)((krow0) + key_) * 128 + kvh_ * 64 + (col_ & 7) * 8; } \
            else { const int q_ = (in_ - 18) * 64 + ln_; const int row_ = q_ / 9, col_ = q_ - row_ * 9; g_ = (vbase) + (size_t)row_ * (ldv) + (col_ & 7) * 8; } \
            __builtin_amdgcn_global_load_lds((const unsigned*)g_, (LAS unsigned*)(F.lds + (buf) * STG + in_ * 1024), 16, 0, 0); } } } while (0)
#define ATT_WAITN(has) do { if (has) { if (F.wave < 4) asm volatile("s_waitcnt vmcnt(5)" ::: "memory"); else asm volatile("s_waitcnt vmcnt(4)" ::: "memory"); } else asm volatile("s_waitcnt vmcnt(0)" ::: "memory"); } while (0)
        { ATT_SRC(0, krow0, vbase, ldv, mode0); (void)mode0; ATT_DMA(0, krow0, vbase, ldv); }
        if (ntile > 1) { ATT_SRC(1, krow1, vbase1, ldv1, mode1); (void)mode1; ATT_DMA(1, krow1, vbase1, ldv1); }
        ATT_WAITN(ntile > 1); lds_barrier();
        for (int j = 0; j < ntile; ++j) {
            asm volatile("; ATT_TILE_BEGIN");
            ATT_SRC(j, krow_c, vbase_c, ldv_c, mode); (void)krow_c; (void)vbase_c; (void)ldv_c;
            const int jb = j % 3;
            if (j + 2 < ntile) { ATT_SRC(j + 2, krow_n, vbase_n, ldv_n, mode_n); (void)mode_n; const int nbuf = (j + 2) % 3; ATT_DMA(nbuf, krow_n, vbase_n, ldv_n); }
            const LAS unsigned char* Kl = F.lds + jb * STG + kvh * 64 * 144;
            const LAS unsigned char* Vl = F.lds + jb * STG + V_OFF + kvh * 64 * 144;
            if (mode == 0) att_tile<0>(Kl, Vl, Qf, O, mrun, lsum, c, h); else if (mode == 1) att_tile<1>(Kl, Vl, Qf, O, mrun, lsum, c, h); else att_tile<2>(Kl, Vl, Qf, O, mrun, lsum, c, h);
            asm volatile("; ATT_TILE_END");
            ATT_WAITN(j + 2 < ntile); lds_barrier();
        }
        asm volatile("; ATT_EPI"); const int tz = F.wave * 64 + lane_id_v();
        const int c2 = tz & 31, h2 = (tz >> 5) & 1, lane2 = tz & 63, wave2 = __builtin_amdgcn_readfirstlane(tz >> 6);
#undef ATT_SRC
#undef ATT_DMA
#undef ATT_WAITN
        const float* gna2 = gin(p, I_GNA) + l * 512 + wave2 * 64;
        float ssq[2];
#pragma unroll
        for (int qb = 0; qb < 2; ++qb) { const float lt = xor32_sum(lsum[qb]); const float inv = 1.0f / lt; float s = 0.f;
#pragma unroll
            for (int db = 0; db < 2; ++db)
#pragma unroll
                for (int i = 0; i < 16; ++i) { O[db][qb][i] *= inv; s += O[db][qb][i] * O[db][qb][i]; }
            s = xor32_sum(s); ssq[qb] = s; if (h2 == 0) SS[wave2 * 64 + 32 * qb + c2] = s; }
        __syncthreads();
#pragma unroll
        for (int qb = 0; qb < 2; ++qb) { float tot = 0.f;
#pragma unroll
            for (int w = 0; w < 8; ++w) tot += SS[w * 64 + 32 * qb + c2];
            const float rstd = 1.0f / sqrtf(tot * (1.0f / 512.0f) + LN_EPS);
            bf16_t* orow = HA + (size_t)(rowbase + 32 * qb + c2) * D + 512 + wave2 * 64;
#pragma unroll
            for (int db = 0; db < 2; ++db) { u32x2 w[4];
#pragma unroll
                for (int g = 0; g < 4; ++g) { const int d0 = 32 * db + 8 * g + 4 * h2; const f32x4 gv = *(const f32x4*)(gna2 + d0);
                    w[g].x = pk2(O[db][qb][4 * g] * rstd * gv[0], O[db][qb][4 * g + 1] * rstd * gv[1]); w[g].y = pk2(O[db][qb][4 * g + 2] * rstd * gv[2], O[db][qb][4 * g + 3] * rstd * gv[3]); }
                if (islat) {
#pragma unroll
                    for (int q = 0; q < 2; ++q) { asm("s_nop 1\n\tv_permlane32_swap_b32 %0, %1" : "+v"(w[q].x), "+v"(w[q + 2].x)); asm("s_nop 1\n\tv_permlane32_swap_b32 %0, %1" : "+v"(w[q].y), "+v"(w[q + 2].y)); }
                    bf16_t* dst = orow + 32 * db + 16 * h2;
                    *(u32x4*)dst = (u32x4){w[0].x, w[0].y, w[2].x, w[2].y}; *(u32x4*)(dst + 8) = (u32x4){w[1].x, w[1].y, w[3].x, w[3].y};
                } else {
#pragma unroll
                    for (int g = 0; g < 4; ++g) { const int d0 = 32 * db + 8 * g + 4 * h2;
                        __hip_atomic_store((unsigned long long*)(orow + d0), ((unsigned long long)w[g].y << 32) | w[g].x, __ATOMIC_RELAXED, __HIP_MEMORY_SCOPE_AGENT); } } } }
        if (!islat) { asm volatile("s_waitcnt vmcnt(0)" ::: "memory"); __syncthreads(); if (F.tid == 0) __hip_atomic_fetch_add(ctxcnt + ((it - 1024) >> 2) * 64, 1u, __ATOMIC_RELAXED, __HIP_MEMORY_SCOPE_AGENT); }
      } else {
        int rowbase; if (it < 1024) rowbase = (it >> 7) * SEQ + (it & 127) * 64; else { const int ci = it - 1024; rowbase = NLAT + (ci >> 2) * CL + (ci & 3) * 64; }
        const int tz3 = F.wave * 64 + lane_id_v(); const int lane2 = tz3 & 63, wave2 = __builtin_amdgcn_readfirstlane(tz3 >> 6);
        { u32x4 ha[4][2], hb[4][2], hg[8];
          const int gq = lane2 >> 2, cc0 = 8 * (lane2 & 3);
#pragma unroll
          for (int j = 0; j < 4; ++j) { const size_t rp = (size_t)((rowbase + 8 * wave2) >> 1) + j; const size_t eo = (((size_t)gq * (NT / 2) + rp) * 32 + cc0) * 2;
              ha[j][0] = *(const u32x4*)(HF + eo); ha[j][1] = *(const u32x4*)(HF + eo + 8); hb[j][0] = *(const u32x4*)(HB + eo); hb[j][1] = *(const u32x4*)(HB + eo + 8); }
#pragma unroll
          for (int t = 0; t < 8; ++t) { const size_t row = (size_t)(rowbase + 8 * wave2 + t); hg[t] = *(const u32x4*)(Gt + row * DR + 8 * lane2); }
          const f32x4 g0 = *(const f32x4*)(gnr + 8 * lane2), g1 = *(const f32x4*)(gnr + 8 * lane2 + 4);
#pragma unroll
          for (int t = 0; t < 8; ++t) { const size_t row = (size_t)(rowbase + 8 * wave2 + t);
              float mv[8]; float s = 0.f;
#pragma unroll
              for (int k = 0; k < 8; ++k) { const unsigned wa = ha[t >> 1][k >> 2][k & 3], wb = hb[t >> 1][k >> 2][k & 3], wg = hg[t][k >> 1];
                  const float hsum = (t & 1) ? bf_hi(wa) + bf_hi(wb) : bf_lo(wa) + bf_lo(wb); const float gk = (k & 1) ? bf_hi(wg) : bf_lo(wg);
                  mv[k] = hsum * gelu_tanh(gk); s += mv[k] * mv[k]; }
              s = wave_sum(s); const float rstd = 1.0f / sqrtf(s * (1.0f / 512.0f) + LN_EPS);
              u32x4 o; o.x = pk2(mv[0] * rstd * g0[0], mv[1] * rstd * g0[1]); o.y = pk2(mv[2] * rstd * g0[2], mv[3] * rstd * g0[3]); o.z = pk2(mv[4] * rstd * g1[0], mv[5] * rstd * g1[1]); o.w = pk2(mv[6] * rstd * g1[2], mv[7] * rstd * g1[3]);
              if (it < 1024) *(u32x4*)(HA + row * D + 8 * lane2) = o;
              else { unsigned long long* d8 = (unsigned long long*)(HA + row * D + 8 * lane2); __hip_atomic_store(d8, ((unsigned long long)o.y << 32) | o.x, __ATOMIC_RELAXED, __HIP_MEMORY_SCOPE_AGENT); __hip_atomic_store(d8 + 1, ((unsigned long long)o.w << 32) | o.z, __ATOMIC_RELAXED, __HIP_MEMORY_SCOPE_AGENT); } } }
        if (it >= 1024) { asm volatile("s_waitcnt vmcnt(0)" ::: "memory"); __syncthreads(); if (F.tid == 0) __hip_atomic_fetch_add(ctxcnt + ((it - 1024) >> 2) * 64, 1u, __ATOMIC_RELAXED, __HIP_MEMORY_SCOPE_AGENT); }
      }
    }
    if (hasctx && F.G == 256 && F.vcu >= 64 && F.vcu < 96) {
        const int j = F.vcu - 64, tile = j >> 2;
        __syncthreads();
        if (F.wave == 0) { unsigned* cw = ctxcnt + tile * 64; unsigned spins = 0;
            while ((unsigned)__builtin_amdgcn_readfirstlane(__hip_atomic_load(cw, __ATOMIC_RELAXED, __HIP_MEMORY_SCOPE_AGENT)) < 8u) { __builtin_amdgcn_s_sleep(4); if (++spins > (1u << 22)) break; }
            __builtin_amdgcn_fence(__ATOMIC_ACQUIRE, "agent"); asm volatile("s_waitcnt vmcnt(0)" ::: "memory"); }
        __syncthreads();
        pg8::OneUnit S; S.pm = NLAT / 256 + tile; S.pn = j & 3; S.K = 1024;
        pg8::EpiPlainBf16 E{(bf16_t*)(F.ws + WS_Y), D, 1.0f};
        pg8::gemm_phase<pg8::EpiPlainBf16, pg8::OneUnit>(F.lds, F.tid, (const bf16_t*)(F.ws + WS_HA), (const bf16_t*)(F.ws + WS_WOUT) + (size_t)l * 1024 * 1024, 1024, S, E);
    }
    if (F.G == 256 && hasctx && F.vcu >= 96) bg_moe_weights(F, p, l + 1, 7);
}

DI void route_block(const Ctx& F, PP p, int l, int row0, int crow0) {
    LAS int* lcnt = (LAS int*)F.lds; LAS int* lbase = lcnt + 32;
    const float* LOG = (const float*)(F.ws + WS_LOG); int* TE = (int*)(F.ws + WS_TOKE); int* TR = (int*)(F.ws + WS_TOKR); float* TG = (float*)(F.ws + WS_TOKG);
    unsigned* gcnt = (unsigned*)(F.ws + WS_CTL) + CW_ECNT + l * 64;
    const float* gb = gin(p, I_RTGB) + l * 4; const float* eb = gin(p, I_RTEB) + l * 32;
    if (F.tid < 32) lcnt[F.tid] = 0;
    __syncthreads();
    const bool act = F.tid < 256 || (crow0 >= 0 && F.tid < 264);
    const int r = F.tid < 256 ? row0 + F.tid : crow0 + (F.tid - 256);
    int e1 = 0, e2 = 0, r1 = 0, r2 = 0; float ga = 0.f, gbb = 0.f;
    if (act) {
        const float* lg = LOG + (size_t)r * 64;
        const bool latr = F.tid < 256; const int fb = (l * 8 + (row0 >> 13)) * 64;
        const float* SNp = (const float*)(F.ws + WS_SNT) + fb; const float* TNp = SNp + 4 * 8 * 64;
        f32x2 st = (f32x2){0.f, 1.f}; if (latr) st = *(const f32x2*)((const float*)(F.ws + WS_ROWST) + 2 * (size_t)r);
        f32x4 g4 = *(const f32x4*)lg;
        if (latr) { const f32x4 sn = *(const f32x4*)SNp, tn = *(const f32x4*)TNp; g4 = (g4 - sn * st.x) * st.y + tn; } else { g4 = g4 + *(const f32x4*)gb; }
        const float g0 = g4[0], g1 = g4[1], g2 = g4[2], g3 = g4[3];
        int gs = 0; float gm = g0; if (g1 > gm) { gm = g1; gs = 1; } if (g2 > gm) { gm = g2; gs = 2; } if (g3 > gm) { gm = g3; gs = 3; }
        const float pg = 1.0f / (__expf(g0 - gm) + __expf(g1 - gm) + __expf(g2 - gm) + __expf(g3 - gm));
        f32x4 ea = *(const f32x4*)(lg + 4 + gs * 8), ec = *(const f32x4*)(lg + 8 + gs * 8);
        if (latr) { ea = (ea - *(const f32x4*)(SNp + 4 + gs * 8) * st.x) * st.y + *(const f32x4*)(TNp + 4 + gs * 8); ec = (ec - *(const f32x4*)(SNp + 8 + gs * 8) * st.x) * st.y + *(const f32x4*)(TNp + 8 + gs * 8); }
        else { ea = ea + *(const f32x4*)(eb + gs * 8); ec = ec + *(const f32x4*)(eb + gs * 8 + 4); }
        float ev[8];
#pragma unroll
        for (int j = 0; j < 4; ++j) { ev[j] = ea[j]; ev[4 + j] = ec[j]; }
        int i1 = 0; float v1 = ev[0];
#pragma unroll
        for (int j = 1; j < 8; ++j) if (ev[j] > v1) { v1 = ev[j]; i1 = j; }
        int i2 = -1; float v2 = -3.0e38f;
#pragma unroll
        for (int j = 0; j < 8; ++j) if (j != i1 && ev[j] > v2) { v2 = ev[j]; i2 = j; }
        const float t = __expf(v2 - v1); ga = pg / (1.0f + t); gbb = pg * t / (1.0f + t);
        e1 = gs * 8 + i1; e2 = gs * 8 + i2;
        r1 = atomicAdd((int*)(lcnt + e1), 1); r2 = atomicAdd((int*)(lcnt + e2), 1);
    }
    __syncthreads();
    if (F.tid < 32) lbase[F.tid] = (int)atomicAdd(gcnt + F.tid, (unsigned)lcnt[F.tid]);
    __syncthreads();
    if (act) { TE[2 * r] = e1; TE[2 * r + 1] = e2; TR[2 * r] = lbase[e1] + r1; TR[2 * r + 1] = lbase[e2] + r2; TG[2 * r] = ga; TG[2 * r + 1] = gbb; }
    __syncthreads();
}
DI void phase_scatter(const Ctx& F, PP p, int l, int ntok) {
    LAS int* pst = (LAS int*)F.lds; LAS int* pcn = pst + 32; LAS int* cn = pst + 64;
    const int* TE = (const int*)(F.ws + WS_TOKE); int* TR = (int*)(F.ws + WS_TOKR); int* ST = (int*)(F.ws + WS_SLOTTOK); int* TILE = (int*)(F.ws + WS_TILEE) + l * 1024;
    unsigned* gcnt = (unsigned*)(F.ws + WS_CTL) + CW_ECNT + l * 64;
    if (F.tid == 0) { int acc = 0; for (int e = 0; e < 32; ++e) { const int cnt = (int)__hip_atomic_load(gcnt + e, __ATOMIC_RELAXED, __HIP_MEMORY_SCOPE_AGENT); const int pc = (cnt + 255) & ~255; pst[e] = acc; pcn[e] = pc; cn[e] = cnt; acc += pc; } pst[96] = acc; }
    __syncthreads();
    for (int idx = F.vcu * 512 + F.tid; idx < 2 * ntok; idx += F.G * 512) { const int e = TE[idx]; const int slot = pst[e] + TR[idx]; ST[slot] = idx >> 1; TR[idx] = slot; }
    for (int e = F.vcu; e < 32; e += F.G) for (int s = pst[e] + cn[e] + F.tid; s < pst[e] + pcn[e]; s += 512) ST[s] = 0;
    if (F.vcu == 0) { for (int t = F.tid; t < 1024; t += 512) { int ee = 0; for (int e = 0; e < 32; ++e) if (t * 256 >= pst[e] && t * 256 < pst[e] + pcn[e]) ee = e; TILE[t] = (t == 1000) ? (pst[96] >> 8) : ee; } }
    __syncthreads();
}

DI void router_ctx_rows(const Ctx& F, int l) {
    const bf16_t* HA = (const bf16_t*)(F.ws + WS_HA); const bf16_t* WR = (const bf16_t*)(F.ws + WS_WR) + (size_t)l * 256 * 1024; float* LOG = (float*)(F.ws + WS_LOG);
    for (int rr = F.vcu * 8 + F.wave; rr < NCTX; rr += F.G * 8) {
        const int r = NLAT + rr; float hv[16];
#pragma unroll
        for (int j = 0; j < 2; ++j) { const u32x4 q = *(const u32x4*)(HA + (size_t)r * D + 8 * F.lane + 512 * j);
#pragma unroll
            for (int i = 0; i < 4; ++i) { hv[8 * j + 2 * i] = bf_lo(q[i]); hv[8 * j + 2 * i + 1] = bf_hi(q[i]); } }
        float mine = 0.f;
        for (int n0 = 0; n0 < 36; n0 += 6) { u32x4 q[6][2];
#pragma unroll
            for (int t = 0; t < 6; ++t)
#pragma unroll
                for (int j = 0; j < 2; ++j) q[t][j] = *(const u32x4*)(WR + (size_t)(n0 + t) * 1024 + 8 * F.lane + 512 * j);
            float a[6];
#pragma unroll
            for (int t = 0; t < 6; ++t) { a[t] = 0.f;
#pragma unroll
                for (int j = 0; j < 2; ++j)
#pragma unroll
                    for (int i = 0; i < 4; ++i) { a[t] += hv[8 * j + 2 * i] * bf_lo(q[t][j][i]); a[t] += hv[8 * j + 2 * i + 1] * bf_hi(q[t][j][i]); } }
#pragma unroll
            for (int t = 0; t < 6; ++t) a[t] = wave_sum(a[t]);
#pragma unroll
            for (int t = 0; t < 6; ++t) mine = (F.lane == n0 + t) ? a[t] : mine; }
        if (F.lane < 36) LOG[(size_t)r * 64 + F.lane] = mine;
    }
}

constexpr int NPHASE = 2 + 9 * DEPTH;
#ifndef MK_MULTI_LAUNCH
#define MK_MULTI_LAUNCH 0
#endif

__global__ void __launch_bounds__(512, 2) mega_fwd(Params p) {
    extern __shared__ __attribute__((aligned(16))) unsigned char lds_raw[];
    LAS unsigned char* const lds0 = (LAS unsigned char*)lds_raw;
    const int wave0 = __builtin_amdgcn_readfirstlane((int)threadIdx.x >> 6);
#define LEADER() (wave0 == 0 && lane_id_v() == 0)
#define MKCTX() Ctx F; { int t_ = wave0 * 64 + lane_id_v(); F.tid = t_; F.lane = t_ & 63; F.wave = __builtin_amdgcn_readfirstlane(t_ >> 6); \
        int g_ = gridDim.x, bx_ = blockIdx.x; asm volatile("" : "+s"(g_), "+s"(bx_)); F.G = g_; F.bx = bx_; F.vcu = (g_ % 8 == 0) ? (bx_ % 8) * (g_ / 8) + bx_ / 8 : bx_; \
        GAS unsigned char* w_ = (GAS unsigned char*)p.ws; GAS float* o_ = (GAS float*)p.out; asm volatile("" : "+s"(w_), "+s"(o_)); F.ws = (unsigned char*)w_; F.out = (float*)o_; F.lds = lds0; } \
        PP pk = (PP)__builtin_amdgcn_kernarg_segment_ptr(); asm volatile("" : "+s"(pk));
    volatile LAS unsigned* MISC = (volatile LAS unsigned*)(lds0 + MISC_OFF);
    if (wave0 == 0) MISC[lane_id_v()] = 0u;
    __syncthreads();
    unsigned* ctl = (unsigned*)(p.ws + WS_CTL);
    XcdBarrier bar; bar.bar = ctl + CW_BAR; bar.x = 0; bar.st = MISC + 8;
    if (p.ph_hi - p.ph_lo > 1) bar = xcd_barrier_post(ctl + CW_BAR, MISC + 8, LEADER());
#ifndef EN_MASK
#define EN_MASK 0xFFFF
#endif
#define EN(b) ((EN_MASK >> (b)) & 1)
#ifndef REP_MASK
#define REP_MASK 0
#endif
#define REPN(b) (((REP_MASK >> (b)) & 1) ? 2 : 1)
#define RUN(k) (p.ph_lo <= (k) && (k) < p.ph_hi)
#define SEAM(k) do { if (RUN(k) && RUN((k) + 1)) xcd_barrier(bar, LEADER()); } while (0)

    if (RUN(0) && EN(11)) for (int rep = 0; rep < REPN(11); ++rep) { MKCTX(); phase_prologue_a(F, pk); } SEAM(0);
    if (RUN(1) && EN(12)) for (int rep = 0; rep < REPN(12); ++rep) { { MKCTX(); router_fold_weights(F, pk); } MKCTX(); phase_rows<0, true>(F, pk, 0, NT); } SEAM(1);

    for (int l = 0; l < DEPTH; ++l) {
        const int pb = 2 + 9 * l;
        const bool lastl = (l == DEPTH - 1);
        const int nrows = lastl ? NLAT : NT;
        if (RUN(pb + 0) && EN(0)) for (int rep = 0; rep < REPN(0); ++rep) { MKCTX();
            pg8::StaticOrder S; S.init(NLAT, DIN, 1024, F.G, F.bx);
            { LAS float* rl = (LAS float*)(F.lds + ROPE_OFF); const float* rg = (const float*)(F.ws + WS_ROPE); for (int i = F.tid; i < 128 * 32; i += 512) rl[i] = rg[i]; }
            __syncthreads();
            pg8::EpiInproj E{(bf16_t*)(F.ws + WS_U), (bf16_t*)(F.ws + WS_G), (bf16_t*)(F.ws + WS_Q), (bf16_t*)(F.ws + WS_KB), (bf16_t*)(F.ws + WS_VT), (bf16_t*)(F.ws + WS_VTC), (const LAS float*)(F.lds + ROPE_OFF)};
            pg8::gemm_phase<pg8::EpiInproj, pg8::StaticOrder>(F.lds, F.tid, (const bf16_t*)(F.ws + WS_HA), (const bf16_t*)(F.ws + WS_WIN) + (size_t)l * DIN * 1024, 1024, S, E);
        } SEAM(pb + 0);
        if (RUN(pb + 1) && EN(1)) for (int rep = 0; rep < REPN(1); ++rep) { MKCTX(); phase_scan(F, pk, l); } SEAM(pb + 1);
        if (RUN(pb + 2) && EN(2)) for (int rep = 0; rep < REPN(2); ++rep) { MKCTX(); phase_attn(F, pk, l); } SEAM(pb + 2);
        if (RUN(pb + 3) && EN(3)) for (int rep = 0; rep < REPN(3); ++rep) { MKCTX();
            pg8::StaticOrder S; S.init(NLAT, 1024, 1024, F.G, F.bx);
            pg8::EpiPlainBf16 E{(bf16_t*)(F.ws + WS_Y), D, 1.0f};
            pg8::gemm_phase<pg8::EpiPlainBf16, pg8::StaticOrder>(F.lds, F.tid, (const bf16_t*)(F.ws + WS_HA), (const bf16_t*)(F.ws + WS_WOUT) + (size_t)l * 1024 * 1024, 1024, S, E);
        } SEAM(pb + 3);
        if (RUN(pb + 4) && EN(4)) for (int rep = 0; rep < REPN(4); ++rep) { MKCTX(); phase_rows<1, false>(F, pk, l, nrows);
            asm volatile("s_waitcnt vmcnt(0)" ::: "memory"); __syncthreads();
            { pg8::OneUnit S; S.pm = F.vcu; S.pn = 0; S.K = 1024; pg8::EpiRouter E{(float*)(F.ws + WS_LOG)};
              pg8::gemm_phase<pg8::EpiRouter, pg8::OneUnit, false, true>(F.lds, F.tid, (const bf16_t*)(F.ws + WS_XB), (const bf16_t*)(F.ws + WS_WRB) + (size_t)(l * 8 + (F.vcu >> 5)) * 64 * 1024, 1024, S, E); }
            if (!lastl) router_ctx_rows(F, l);
            asm volatile("s_waitcnt vmcnt(0)" ::: "memory"); __syncthreads();
            route_block(F, pk, l, 256 * F.vcu, lastl ? -1 : NLAT + 8 * F.vcu);
        } SEAM(pb + 4);
        if (RUN(pb + 5) && EN(7)) for (int rep = 0; rep < REPN(7); ++rep) { MKCTX(); phase_scatter(F, pk, l, nrows); if (l >= 1) bg_moe_weights(F, pk, l, -1);   } SEAM(pb + 5);
        if (RUN(pb + 6) && EN(8)) for (int rep = 0; rep < REPN(8); ++rep) { MKCTX();
            const int* TILE = (const int*)(F.ws + WS_TILEE) + l * 1024; const int ntiles = __builtin_amdgcn_readfirstlane(TILE[1000]);
            LAS int* toktab = (LAS int*)(F.lds + TOKTAB_OFF);
            pg8::MoeOrder<true> S; S.ntiles = ntiles; S.nN = 4; S.G = F.G; S.c = F.vcu; S.K = 512; S.tile_e = TILE; S.estride = (size_t)1024 * 1024; S.toktab = toktab;
            { const int* ST = (const int*)(F.ws + WS_SLOTTOK); pg8::Unit u; for (int i = 0; i < 12 && S.next(i, u); ++i) if (F.tid < 256) toktab[i * 256 + F.tid] = ST[u.pm * 256 + F.tid]; }
            __syncthreads();
            pg8::EpiSwigluF8 E{(unsigned char*)(F.ws + WS_HMOE)};
            pg8::gemm_phase<pg8::EpiSwigluF8, pg8::MoeOrder<true>, true>(F.lds, F.tid, (const bf16_t*)(F.ws + WS_HA8), (const bf16_t*)(F.ws + WS_W13 + (size_t)l * NE * 1024 * 1024), 512, S, E);
            if ((ntiles * 4) % F.G != 0 && F.vcu >= (ntiles * 4) % F.G) bg_moe_weights(F, pk, l + 1, 4);
        } SEAM(pb + 6);
        if (RUN(pb + 7) && EN(9)) for (int rep = 0; rep < REPN(9); ++rep) { MKCTX();
            const int* TILE = (const int*)(F.ws + WS_TILEE) + l * 1024; const int ntiles = __builtin_amdgcn_readfirstlane(TILE[1000]);
            pg8::MoeOrder<false> S; S.ntiles = ntiles; S.nN = 4; S.G = F.G; S.c = F.vcu; S.K = 256; S.tile_e = TILE; S.estride = (size_t)1024 * DE; S.toktab = nullptr;
            pg8::EpiPlainF8 E{(unsigned char*)(F.ws + WS_YMOE), D, pg8::F8_SY / (pg8::F8_SH * pg8::F8_SW2)};
            pg8::gemm_phase<pg8::EpiPlainF8, pg8::MoeOrder<false>, true>(F.lds, F.tid, (const bf16_t*)(F.ws + WS_HMOE), (const bf16_t*)(F.ws + WS_W2 + (size_t)l * NE * 1024 * DE), 256, S, E);
            if ((ntiles * 4) % F.G != 0 && F.vcu >= (ntiles * 4) % F.G) bg_moe_weights(F, pk, l + 1, 3);
        } SEAM(pb + 7);
        if (RUN(pb + 8) && EN(10)) for (int rep = 0; rep < REPN(10); ++rep) { MKCTX(); if (lastl) phase_rows<2, false>(F, pk, l, nrows); else phase_rows<2, true>(F, pk, l, nrows); } SEAM(pb + 8);
    }
#undef RUN
#undef SEAM
}

extern "C" void kernel_launch(void* const* d_in, const int* in_sizes, int n_in, void* d_out, int out_size, void* d_ws, size_t ws_size, hipStream_t stream) {
    static int grid = 0;
    if (grid == 0) {
        if (n_in != 29 || out_size != NLAT * D || ws_size < WS_END) { fprintf(stderr, "kernel_launch: unexpected shapes (n_in %d out %d ws %zu, need %zu)\n", n_in, out_size, ws_size, (size_t)WS_END); grid = -1; return; }
        int dev = 0, cus = 0, per_cu = 0;
        if (hipGetDevice(&dev) != hipSuccess || hipDeviceGetAttribute(&cus, hipDeviceAttributeMultiprocessorCount, dev) != hipSuccess) { grid = -1; return; }
        if (hipFuncSetAttribute((const void*)mega_fwd, hipFuncAttributeMaxDynamicSharedMemorySize, LDS_BYTES) != hipSuccess) { fprintf(stderr, "kernel_launch: hipFuncSetAttribute failed\n"); grid = -1; return; }
        if (hipOccupancyMaxActiveBlocksPerMultiprocessor(&per_cu, (const void*)mega_fwd, 512, LDS_BYTES) != hipSuccess || per_cu < 1) fprintf(stderr, "kernel_launch: occupancy query says %d\n", per_cu);
        (void)hipGetLastError();
        grid = cus;
    }
    if (grid < 0) return;
    (void)hipMemsetAsync((char*)d_ws + WS_CTL, 0, CTL_ZERO_BYTES, stream);
    Params p{};
    for (int i = 0; i < 29; ++i) p.in[i] = (const float*)d_in[i];
    p.out = (float*)d_out; p.ws = (unsigned char*)d_ws;
#if MK_MULTI_LAUNCH
    for (int k = 0; k < NPHASE; ++k) { p.ph_lo = k; p.ph_hi = k + 1; hipLaunchKernelGGL(mega_fwd, dim3(grid), dim3(512), LDS_BYTES, stream, p); }
#else
    p.ph_lo = 0; p.ph_hi = NPHASE;
    hipLaunchKernelGGL(mega_fwd, dim3(grid), dim3(512), LDS_BYTES, stream, p);
#endif
    const hipError_t le = hipPeekAtLastError();
    if (le != hipSuccess) fprintf(stderr, "kernel_launch: launch failed: %s\n", hipGetErrorName(le));
}
```

```cpp
#include <hip/hip_runtime.h>
#include <cstdio>
#include <cstdint>

#define DI __device__ __forceinline__
#define LAS __attribute__((address_space(3)))
#define GAS __attribute__((address_space(1)))

typedef unsigned short bf16_t;
typedef short bf16x8 __attribute__((ext_vector_type(8)));
typedef short s16x4 __attribute__((ext_vector_type(4)));
typedef float f32x4 __attribute__((ext_vector_type(4)));
typedef float f32x2 __attribute__((ext_vector_type(2)));
typedef float f32x16 __attribute__((ext_vector_type(16)));
typedef unsigned u32x4 __attribute__((ext_vector_type(4)));
typedef unsigned u32x2 __attribute__((ext_vector_type(2)));

constexpr int D = 1024, NB = 8, SEQ = 8192, DEPTH = 4, CL = 256;
constexpr int NLAT = NB * SEQ, NCTX = NB * CL, NT = NLAT + NCTX;
constexpr int DIN = 1792, DR = 512;
constexpr int NE = 32, DE = 512;
constexpr int MPAD = 143360;
constexpr float ALPHA = 1.6817928305074292f;
constexpr float LN_EPS = 1e-6f;
constexpr float LOG2E = 1.4426950408889634f;

constexpr size_t MiB = 1u << 20;
constexpr size_t WS_CTL = 0, CTL_ZERO_BYTES = 1 * MiB;
constexpr size_t WS_MOD = 1 * MiB;
constexpr size_t WS_ROPE = 2 * MiB;
constexpr size_t WS_SNT = 2 * MiB + 131072;
constexpr size_t WS_ROWST = 2 * MiB + 262144;
constexpr size_t WS_TILEE = 2 * MiB + 65536;
constexpr size_t WS_WIN = 3 * MiB;
constexpr size_t WS_WOUT = 17 * MiB;
constexpr size_t WS_WR = 25 * MiB;
constexpr size_t WS_W13 = 27 * MiB;
constexpr size_t WS_XB = 155 * MiB;
constexpr size_t WS_W2 = 283 * MiB;
constexpr size_t WS_WRB = 347 * MiB;
constexpr size_t WS_DUMMY = 352 * MiB;
constexpr size_t WS_XC = 411 * MiB;
constexpr size_t WS_HA = 419 * MiB;
constexpr size_t WS_LOG = 551 * MiB;
constexpr size_t WS_TOKE = 568 * MiB;
constexpr size_t WS_TOKG = 569 * MiB;
constexpr size_t WS_TOKR = 570 * MiB;
constexpr size_t WS_SLOTTOK = 571 * MiB;
constexpr size_t WS_R = 572 * MiB;
constexpr size_t WS_U = WS_R, WS_G = WS_R + 66 * MiB, WS_Q = WS_R + 132 * MiB, WS_KB = WS_R + 198 * MiB, WS_VT = WS_R + 215 * MiB;
constexpr size_t WS_VTC = WS_VT + 16 * MiB;
constexpr size_t WS_HF = WS_R + 232 * MiB, WS_HB = WS_R + 298 * MiB, WS_Y = WS_R + 364 * MiB;
constexpr size_t WS_XCV = WS_R + 364 * MiB;
constexpr size_t WS_HMOE = WS_R, WS_YMOE = WS_R + 232 * MiB;
constexpr size_t WS_HA8 = WS_R + 232 * MiB;
constexpr size_t WS_END = WS_R + 496 * MiB;
static_assert(WS_KB + (size_t)NT * 128 * 2 <= WS_VT && WS_VTC + (size_t)NB * 2 * 64 * CL * 2 <= WS_HF && WS_Y + (size_t)NT * D * 2 <= WS_END, "ws map");
static_assert(WS_W13 + (size_t)DEPTH * NE * 1024 * 1024 <= WS_XB && WS_XB + (size_t)NLAT * D * 2 <= WS_W2, "ws map xb");
static_assert(WS_HMOE + (size_t)MPAD * DE <= WS_HA8 && WS_VTC + (size_t)NB * 2 * 64 * CL * 2 <= WS_YMOE && WS_YMOE + (size_t)MPAD * D <= WS_END, "ws map moe");
constexpr int CW_BAR = 4096;
constexpr int CW_ECNT = 8192;
constexpr int CW_CTXIN = 16384;
constexpr int CW_SCANX = 32768;
constexpr int CW_BGQ = 24576;
constexpr int CW_CTXMIX = 12288;

constexpr int LDS_BYTES = 148480;
constexpr int TOKTAB_OFF = 131072;
constexpr int ROPE_OFF = 131072;
constexpr int MISC_OFF = 131072 + 16384;

DI unsigned f2bf(float f) { unsigned u = __float_as_uint(f); return (u + 0x7fffu + ((u >> 16) & 1u)) >> 16; }
DI unsigned pk2(float lo, float hi) { unsigned r; asm("v_cvt_pk_bf16_f32 %0, %1, %2" : "=v"(r) : "v"(lo), "v"(hi)); return r; }
typedef _Float16 f16x2 __attribute__((ext_vector_type(2)));
DI unsigned pkh2(float lo, float hi) { const f16x2 t = {(_Float16)lo, (_Float16)hi}; return __builtin_bit_cast(unsigned, t); }
DI f32x2 unpkh2(unsigned u) { const f16x2 t = __builtin_bit_cast(f16x2, u); return (f32x2){(float)t.x, (float)t.y}; }
DI float bf_lo(unsigned u) { return __uint_as_float(u << 16); }
DI float bf_hi(unsigned u) { return __uint_as_float(u & 0xffff0000u); }
DI float bf2f(bf16_t b) { return __uint_as_float(((unsigned)b) << 16); }
template <int CTRL, int ROWMASK = 0xf> DI float dpp_mov(float v) { return __builtin_bit_cast(float, __builtin_amdgcn_update_dpp(0, __builtin_bit_cast(int, v), CTRL, ROWMASK, 0xf, ROWMASK == 0xf)); }
DI float wave_sum(float v) {
    v += dpp_mov<0xB1>(v); v += dpp_mov<0x4E>(v); v += dpp_mov<0x141>(v); v += dpp_mov<0x140>(v);
    v += dpp_mov<0x142, 0xa>(v); v += dpp_mov<0x143, 0xc>(v);
    return __builtin_bit_cast(float, __builtin_amdgcn_readlane(__builtin_bit_cast(int, v), 63));
}
DI float xor32_max(float v) { float a = v, b = v; asm("s_nop 1\n\tv_permlane32_swap_b32 %0, %1" : "+v"(a), "+v"(b)); return fmaxf(a, b); }
DI float xor32_sum(float v) { float a = v, b = v; asm("s_nop 1\n\tv_permlane32_swap_b32 %0, %1" : "+v"(a), "+v"(b)); return a + b; }
DI int lane_id_v() { int l; asm volatile("v_mbcnt_lo_u32_b32 %0, -1, 0\n\tv_mbcnt_hi_u32_b32 %0, -1, %0" : "=v"(l)); return l; }
DI void lds_barrier() { asm volatile("s_waitcnt lgkmcnt(0)" ::: "memory"); __builtin_amdgcn_s_barrier(); asm volatile("" ::: "memory"); }
DI float f8clamp(float x) { return __builtin_amdgcn_fmed3f(x, -448.0f, 448.0f); }
DI float fast_exp2(float x) { return __builtin_amdgcn_exp2f(x); }
DI float fast_rcp(float x) { return __builtin_amdgcn_rcpf(x); }
DI float sigmoidf_(float x) { return fast_rcp(1.0f + fast_exp2(-x * LOG2E)); }
DI float gelu_tanh(float x) {
    const float u = 0.7978845608028654f * (x + 0.044715f * x * x * x);
    return x * sigmoidf_(2.0f * u);
}

DI unsigned swap1(unsigned v) { return (unsigned)__builtin_amdgcn_update_dpp(0, (int)v, 0xB1, 0xf, 0xf, true); }
DI u32x4 swap1(u32x4 v) { return (u32x4){swap1(v.x), swap1(v.y), swap1(v.z), swap1(v.w)}; }
DI u32x2 swap1(u32x2 v) { return (u32x2){swap1(v.x), swap1(v.y)}; }
DI int wblk(int nb) { return (nb & ~7) | ((nb & 1) * 4 + ((nb >> 1) & 3)); }

#define XB_TMO      128
#define XB_XCNT(j)  (256  + 64 * (j))
#define XB_XSUB(j)  (1280 + 64 * (j))
#define XB_XGEN(j)  (2304 + 64 * (j))
#define XB_TOP      3328
#define XB_TOPGEN   3392
#define XCD_BAR_WORDS 3456
#define XB_SPIN_CAP (1u << 18)

__device__ __forceinline__ unsigned xb_ld(unsigned* p)              { return __hip_atomic_load(p, __ATOMIC_RELAXED, __HIP_MEMORY_SCOPE_AGENT); }
__device__ __forceinline__ unsigned xb_add(unsigned* p, unsigned v) { return __hip_atomic_fetch_add(p, v, __ATOMIC_RELAXED, __HIP_MEMORY_SCOPE_AGENT); }
__device__ __forceinline__ unsigned xb_xcc_id() { return (unsigned)__builtin_amdgcn_s_getreg((3 << 11) | 20) & 0xFu; }
#define XB_SPIN(cond, bar) do { unsigned _sp = 0; while (cond) { __builtin_amdgcn_s_sleep(1); \
    if ((++_sp & 255u) == 0u) { if (xb_ld(&(bar)[XB_TMO])) break; if (_sp > XB_SPIN_CAP) { atomicAdd(&(bar)[XB_TMO], 1u); break; } } } } while (0)

struct XcdBarrier { unsigned* bar; unsigned x; volatile LAS unsigned* st; };

__device__ __forceinline__ XcdBarrier xcd_barrier_post(unsigned* bar, volatile LAS unsigned* st, const bool leader) {
    XcdBarrier b; b.bar = bar; b.x = xb_xcc_id(); b.st = st;
    if (leader) (void)xb_add(&bar[XB_XCNT(b.x)], 1u);
    return b;
}
__device__ __forceinline__ void xcd_barrier_complete(unsigned* bar, unsigned x, unsigned& nloc, unsigned& nx) {
    const unsigned G = gridDim.x * gridDim.y * gridDim.z;
    unsigned sum, cnt, mine, sp = 0u;
    for (;;) {
        sum = 0u; cnt = 0u; mine = 0u;
        unsigned cv[16];
#pragma unroll
        for (unsigned j = 0; j < 16; ++j) asm volatile("global_load_dword %0, %1, off sc1" : "=v"(cv[j]) : "v"(&bar[XB_XCNT(j)]) : "memory");
        asm volatile("s_waitcnt vmcnt(0)" : "+v"(cv[0]), "+v"(cv[1]), "+v"(cv[2]), "+v"(cv[3]), "+v"(cv[4]), "+v"(cv[5]), "+v"(cv[6]), "+v"(cv[7]), "+v"(cv[8]), "+v"(cv[9]), "+v"(cv[10]), "+v"(cv[11]), "+v"(cv[12]), "+v"(cv[13]), "+v"(cv[14]), "+v"(cv[15]) :: "memory");
#pragma unroll
        for (unsigned j = 0; j < 16; ++j) { const unsigned c = cv[j]; sum += c; cnt += (c > 0u) ? 1u : 0u; mine = (j == x) ? c : mine; }
        if (sum == G) break;
        __builtin_amdgcn_s_sleep(1);
        if ((++sp & 255u) == 0u) { if (xb_ld(&bar[XB_TMO])) break; if (sp > XB_SPIN_CAP) { atomicAdd(&bar[XB_TMO], 1u); break; } }
    }
    nloc = mine > 0u ? mine : 1u; nx = cnt > 0u ? cnt : 1u;
}
__device__ __forceinline__ void xcd_barrier(const XcdBarrier& b, const bool leader) {
    asm volatile("s_waitcnt vmcnt(0)" ::: "memory");
    __syncthreads();
    if (leader) {
        unsigned* bar = b.bar;
        __builtin_amdgcn_s_waitcnt(0);
        unsigned nloc = b.st[0], nx = b.st[1];
        if (nloc == 0u) { xcd_barrier_complete(bar, b.x, nloc, nx); b.st[0] = nloc; b.st[1] = nx; }
        const unsigned old = xb_add(&bar[XB_XSUB(b.x)], 1u);
        const unsigned gen = old / nloc;
        if (old + 1u == (gen + 1u) * nloc) {
            __builtin_amdgcn_fence(__ATOMIC_RELEASE, "agent");
            asm volatile("s_waitcnt vmcnt(0)" ::: "memory");
            const unsigned og = xb_add(&bar[XB_TOP], 1u);
            const unsigned tg = og / nx;
            if (og + 1u == (tg + 1u) * nx) xb_add(&bar[XB_TOPGEN], 1u);
            else XB_SPIN(xb_ld(&bar[XB_TOPGEN]) == tg, bar);
            __builtin_amdgcn_fence(__ATOMIC_ACQUIRE, "agent");
            xb_add(&bar[XB_XGEN(b.x)], 1u);
            asm volatile("s_waitcnt vmcnt(0)" ::: "memory");
        } else {
            XB_SPIN(xb_ld(&bar[XB_XGEN(b.x)]) == gen, bar);
            __builtin_amdgcn_fence(__ATOMIC_ACQUIRE, "agent");
            asm volatile("s_waitcnt vmcnt(0)" ::: "memory");
        }
    }
    __syncthreads();
}

namespace pg8 {
constexpr int BM = 256, BK = 64, HALF = 128, HTB = HALF * BK * 2, STAGE_BYTES = 8 * HTB, NXCD = 8, WGM = 8;
__host__ __device__ __forceinline__ int lds_byte(int r, int c) { const int st = (r >> 4) * 2 + (c >> 5), rr = r & 15, cc = c & 31, ob = rr * 64 + cc * 2; return st * 1024 + (ob ^ (((ob >> 9) & 1) << 5)); }
__host__ __device__ __forceinline__ void stage_rc(int b, int& R, int& C) { const int st = b / 1024, sb = b % 1024, swz = sb ^ (((sb >> 9) & 1) << 5); R = (st >> 1) * 16 + swz / 64; C = (st & 1) * 32 + (swz % 64) / 2; }

struct Unit { int pm, pn; };

struct StaticOrder {
    static constexpr bool GATHER = false;
    int nM, nN, nwg, G, c, K, wgm = WGM;
    __device__ __forceinline__ void init(int M, int N, int K_, int G_, int c_) { nM = M / BM; nN = N / BM; nwg = nM * nN; G = G_; c = c_; K = K_; }
    __device__ __forceinline__ bool next(int i, Unit& u) const {
        const long L = (long)i * G + c; if (L >= nwg) return false;
        int wgid = (int)L; { const int q = nwg / NXCD, r = nwg % NXCD, xcd = wgid % NXCD, off = wgid / NXCD; wgid = (xcd < r ? xcd * (q + 1) : r * (q + 1) + (xcd - r) * q) + off; }
        const int nig = wgm * nN, gid = wgid / nig, fm = gid * wgm, gsz = (nM - fm) < wgm ? (nM - fm) : wgm;
        u.pm = fm + ((wgid % nig) % gsz); u.pn = (wgid % nig) / gsz; return true;
    }
    __device__ __forceinline__ size_t b_off(const Unit& u) const { return (size_t)u.pn * BM * K * 2; }
    __device__ __forceinline__ LAS const int* tok(int) const { return nullptr; }
};
struct OneUnit {
    static constexpr bool GATHER = false; int pm, pn, K;
    __device__ __forceinline__ bool next(int i, Unit& u) const { if (i != 0) return false; u.pm = pm; u.pn = pn; return true; }
    __device__ __forceinline__ size_t b_off(const Unit& u) const { return (size_t)u.pn * BM * K * 2; }
    __device__ __forceinline__ LAS const int* tok(int) const { return nullptr; }
};
template <bool GATHER_> struct MoeOrder {
    static constexpr bool GATHER = GATHER_;
    int ntiles, nN, G, c, K; const int* tile_e; size_t estride; LAS const int* toktab;
    __device__ __forceinline__ bool next(int i, Unit& u) const { const long L = (long)i * G + c; if (L >= (long)ntiles * nN) return false; u.pm = (int)(L / nN); u.pn = (int)(L % nN); return true; }
    __device__ __forceinline__ size_t b_off(const Unit& u) const { return (size_t)__builtin_amdgcn_readfirstlane(tile_e[u.pm]) * estride + (size_t)u.pn * BM * K * 2; }
    __device__ __forceinline__ LAS const int* tok(int ui) const { return toktab + ui * 256; }
};

typedef int i32x8 __attribute__((ext_vector_type(8)));
typedef _Float16 f16x8 __attribute__((ext_vector_type(8)));
typedef int i32x4 __attribute__((ext_vector_type(4)));
template <class Epi, class Sched, bool FP8 = false, bool F16 = false>
__device__ __forceinline__ void gemm_phase(LAS unsigned char* lds, const int tid, const bf16_t* Ap, const bf16_t* Btp, const int K, const Sched& S, const Epi& E) {
    const int wid = __builtin_amdgcn_readfirstlane(tid >> 6), lane = tid & 63, wr = wid >> 2, wc = wid & 3, fr = lane & 15, fq = lane >> 4;
    const int nt = K / BK;
    unsigned voffA[2], voffB[2];
#pragma unroll
    for (int i = 0; i < 2; ++i) { int R, C; stage_rc(tid * 16 + i * 8192, R, C); voffA[i] = (unsigned)(R * K + C) * 2u; voffB[i] = voffA[i]; }
    unsigned gvC[2][2], gvN[2][2];
    const size_t kstep = (size_t)(BK * 2);
    const size_t hstep = (size_t)HALF * K * 2;
    const size_t tstep = 2 * hstep;
    const unsigned ldsw = (unsigned)wid * 1024u;
    const int aoff = lds_byte(wr * 64 + fr, fq * 8), boff = lds_byte(wc * 32 + fr, fq * 8);
#define PG8_SA(b, h) (((b) * 2 + (h)) * HTB)
#define PG8_SB(b, h) ((4 + (b) * 2 + (h)) * HTB)
#define PG8_STAGE2C(bufoff, gbase, v0, v1, CP) do { \
        __builtin_amdgcn_global_load_lds((const unsigned*)((const char*)(gbase) + (v0)), (LAS unsigned*)(lds + (bufoff) + ldsw), 16, 0, CP); \
        __builtin_amdgcn_global_load_lds((const unsigned*)((const char*)(gbase) + (v1)), (LAS unsigned*)(lds + (bufoff) + ldsw + 8192), 16, 0, CP); } while (0)
#define PG8_STAGE2(bufoff, gbase, v0, v1) PG8_STAGE2C(bufoff, gbase, v0, v1, 0)
#define PG8_STAGEB(bufoff, gbase) PG8_STAGE2(bufoff, gbase, voffB[0], voffB[1])
#define PG8_STAGEA(bufoff, sel, h, kb) do { if constexpr (Sched::GATHER) { const unsigned _v0 = (sel) ? gvN[h][0] : gvC[h][0], _v1 = (sel) ? gvN[h][1] : gvC[h][1]; PG8_STAGE2(bufoff, (const char*)Ap + (kb), _v0, _v1); } \
        else { PG8_STAGE2C(bufoff, ((sel) ? nA : cA) + (size_t)(h) * hstep + (kb), voffA[0], voffA[1], (F16 ? 2 : 0)); } } while (0)
#define PG8_LDA(dst, b, h) do { _Pragma("unroll") for (int m = 0; m < 4; ++m) _Pragma("unroll") for (int k = 0; k < 2; ++k) dst[m][k] = *(const LAS bf16x8*)(lds + PG8_SA(b, h) + aoff + m * 2048 + k * 1024); } while (0)
#define PG8_LDB(dst, b, h) do { _Pragma("unroll") for (int n = 0; n < 2; ++n) _Pragma("unroll") for (int k = 0; k < 2; ++k) dst[n][k] = *(const LAS bf16x8*)(lds + PG8_SB(b, h) + boff + n * 2048 + k * 1024); } while (0)
#define PG8_CAT8(x0, x1) __builtin_shufflevector(__builtin_bit_cast(i32x4, x0), __builtin_bit_cast(i32x4, x1), 0, 1, 2, 3, 4, 5, 6, 7)
#define PG8_MMA(ai, bj, At, Bt) do { __builtin_amdgcn_s_setprio(1); if constexpr (FP8) { _Pragma("unroll") for (int m = 0; m < 4; ++m) _Pragma("unroll") for (int n = 0; n < 2; ++n) { \
            const i32x8 _a = PG8_CAT8(Bt[n][0], Bt[n][1]), _b = PG8_CAT8(At[m][0], At[m][1]); \
            asm volatile("v_mfma_scale_f32_16x16x128_f8f6f4 %0, %1, %2, %0, %3, %3 op_sel_hi:[0,0,0]" : "+v"(acc[ai][bj][m][n]) : "v"(_a), "v"(_b), "v"(f8one)); } }   \
        else if constexpr (F16) { _Pragma("unroll") for (int m = 0; m < 4; ++m) _Pragma("unroll") for (int n = 0; n < 2; ++n) _Pragma("unroll") for (int k = 0; k < 2; ++k) \
        acc[ai][bj][m][n] = __builtin_amdgcn_mfma_f32_16x16x32_f16(__builtin_bit_cast(f16x8, Bt[n][k]), __builtin_bit_cast(f16x8, At[m][k]), acc[ai][bj][m][n], 0, 0, 0); } \
        else { _Pragma("unroll") for (int m = 0; m < 4; ++m) _Pragma("unroll") for (int n = 0; n < 2; ++n) _Pragma("unroll") for (int k = 0; k < 2; ++k) \
        acc[ai][bj][m][n] = __builtin_amdgcn_mfma_f32_16x16x32_bf16(Bt[n][k], At[m][k], acc[ai][bj][m][n], 0, 0, 0); } __builtin_amdgcn_s_setprio(0); } while (0)
#define PG8_WAIT_V(n) asm volatile("s_waitcnt vmcnt(" #n ")" ::: "memory")
#define PG8_WAIT_L(n) asm volatile("s_waitcnt lgkmcnt(" #n ")" ::: "memory")
#define PG8_BAR __builtin_amdgcn_s_barrier()
#define PG8_SCHED __builtin_amdgcn_sched_barrier(0)
#define PG8_GV(dst, ui_) do { if constexpr (Sched::GATHER) { LAS const int* _tt = S.tok(ui_); _Pragma("unroll") for (int _h = 0; _h < 2; ++_h) _Pragma("unroll") for (int _i = 0; _i < 2; ++_i) \
        { int _R, _C; stage_rc(tid * 16 + _i * 8192, _R, _C); dst[_h][_i] = ((unsigned)_tt[_h * 128 + _R] * (unsigned)K + (unsigned)_C) * 2u; } } } while (0)
    Unit cur, nxt; int ui = 0;
    if (!S.next(0, cur)) return;
    int f8one = 0x7f7f7f7f; asm volatile("" : "+v"(f8one));
    f32x4 acc[2][2][4][2];
#pragma unroll
    for (int a = 0; a < 2; ++a)
#pragma unroll
        for (int b = 0; b < 2; ++b)
#pragma unroll
            for (int m = 0; m < 4; ++m)
#pragma unroll
                for (int n = 0; n < 2; ++n) acc[a][b][m][n] = (f32x4){0.f, 0.f, 0.f, 0.f};
    bf16x8 At[4][2], B0[2][2], B1[2][2];
    const char* cA = (const char*)Ap + (size_t)cur.pm * tstep; const char* cB = (const char*)Btp + S.b_off(cur);
    const char* nA = cA; const char* nB = cB;
    PG8_GV(gvC, 0);
#pragma unroll
    for (int _h = 0; _h < 2; ++_h) { gvN[_h][0] = gvC[_h][0]; gvN[_h][1] = gvC[_h][1]; }
    asm volatile("" ::: "memory");
    PG8_STAGEB(PG8_SB(0, 0), cB); PG8_STAGEA(PG8_SA(0, 0), false, 0, 0); PG8_STAGEB(PG8_SB(0, 1), cB + hstep); PG8_STAGEA(PG8_SA(0, 1), false, 1, 0);
    if (wr == 1) PG8_BAR;
    PG8_WAIT_V(4); PG8_BAR;
    PG8_STAGEB(PG8_SB(1, 0), cB + kstep); PG8_STAGEA(PG8_SA(1, 0), false, 0, kstep); PG8_STAGEB(PG8_SB(1, 1), cB + hstep + kstep);
    PG8_WAIT_V(6); PG8_BAR;
    for (;;) {
        const bool has_next = S.next(ui + 1, nxt);
        nA = has_next ? (const char*)Ap + (size_t)nxt.pm * tstep : cA; nB = has_next ? (const char*)Btp + S.b_off(nxt) : cB;
        if (has_next) { PG8_GV(gvN, ui + 1); }
#pragma unroll 1
        for (int t = 0; t < nt; t += 2) {
            const bool last = (t == nt - 2);
            const size_t k1 = (size_t)(t + 1) * kstep;
            const size_t k2 = last ? 0 : (size_t)(t + 2) * kstep;
            const char* b2 = last ? nB : cB + (size_t)(t + 2) * kstep;
            const size_t k3 = k2 + kstep; const char* b3 = b2 + kstep;
            PG8_LDB(B0, 0, 0); PG8_SCHED; PG8_LDA(At, 0, 0); PG8_STAGEA(PG8_SA(1, 1), false, 1, k1);
            PG8_WAIT_L(8); PG8_BAR; PG8_WAIT_L(0); PG8_MMA(0, 0, At, B0); PG8_BAR; PG8_SCHED;
            PG8_LDB(B1, 0, 1); PG8_STAGEB(PG8_SB(0, 0), b2);
            PG8_BAR; PG8_WAIT_L(0); PG8_MMA(0, 1, At, B1); PG8_BAR;
            PG8_LDA(At, 0, 1); PG8_STAGEA(PG8_SA(0, 0), last, 0, k2);
            PG8_BAR; PG8_WAIT_L(0); PG8_MMA(1, 0, At, B0); PG8_BAR; PG8_SCHED;
            PG8_STAGEB(PG8_SB(0, 1), b2 + hstep);
            PG8_WAIT_V(6); PG8_BAR; PG8_MMA(1, 1, At, B1); PG8_BAR;
            PG8_LDB(B0, 1, 0); PG8_SCHED; PG8_LDA(At, 1, 0); PG8_STAGEA(PG8_SA(0, 1), last, 1, k2);
            PG8_WAIT_L(8); PG8_BAR; PG8_WAIT_L(0); PG8_MMA(0, 0, At, B0); PG8_BAR; PG8_SCHED;
            PG8_LDB(B1, 1, 1); PG8_STAGEB(PG8_SB(1, 0), b3);
            PG8_BAR; PG8_WAIT_L(0); PG8_MMA(0, 1, At, B1); PG8_BAR;
            PG8_LDA(At, 1, 1); PG8_STAGEA(PG8_SA(1, 0), last, 0, k3);
            PG8_BAR; PG8_WAIT_L(0); PG8_MMA(1, 0, At, B0); PG8_BAR; PG8_SCHED;
            PG8_STAGEB(PG8_SB(1, 1), b3 + hstep);
            PG8_WAIT_V(6); PG8_BAR; PG8_MMA(1, 1, At, B1); PG8_BAR;
        }
        if constexpr (FP8) asm volatile("s_nop 15\n\ts_nop 15" ::: "memory");
        E(acc, cur, wr, wc, fr, fq);
        if (!has_next) break;
#pragma unroll
        for (int a = 0; a < 2; ++a)
#pragma unroll
            for (int b = 0; b < 2; ++b)
#pragma unroll
                for (int m = 0; m < 4; ++m)
#pragma unroll
                    for (int n = 0; n < 2; ++n) acc[a][b][m][n] = (f32x4){0.f, 0.f, 0.f, 0.f};
        cur = nxt; cA = nA; cB = nB; ++ui;
#pragma unroll
        for (int _h = 0; _h < 2; ++_h) { gvC[_h][0] = gvN[_h][0]; gvC[_h][1] = gvN[_h][1]; }
    }
    PG8_WAIT_V(0);
    if (wr == 0) PG8_BAR;
    PG8_BAR;
#undef PG8_SA
#undef PG8_SB
#undef PG8_STAGE2
#undef PG8_STAGE2C
#undef PG8_STAGEA
#undef PG8_STAGEB
#undef PG8_LDA
#undef PG8_LDB
#undef PG8_MMA
#undef PG8_CAT8
#undef PG8_WAIT_V
#undef PG8_WAIT_L
#undef PG8_BAR
#undef PG8_SCHED
#undef PG8_GV
}

struct EpiPlainBf16 {
    bf16_t* O; int ldc; float scale;
    DI void operator()(const f32x4 (&acc)[2][2][4][2], const Unit& u, int wr, int wc, int fr, int fq) const {
        const int odd = fr & 1; const int rowb = u.pm * BM + wr * 64 + (fr - odd), colb = u.pn * BM + wc * 64 + odd * 32 + 8 * fq;
#pragma unroll
        for (int ai = 0; ai < 2; ++ai)
#pragma unroll
            for (int m = 0; m < 4; ++m) { u32x4 X[2];
#pragma unroll
                for (int bj = 0; bj < 2; ++bj) { const f32x4 v0 = acc[ai][bj][m][0] * scale, v1 = acc[ai][bj][m][1] * scale; X[bj].x = pk2(v0[0], v0[1]); X[bj].y = pk2(v0[2], v0[3]); X[bj].z = pk2(v1[0], v1[1]); X[bj].w = pk2(v1[2], v1[3]); }
                const u32x4 recv = swap1(odd ? X[0] : X[1]);
                bf16_t* rowp = O + (size_t)(rowb + ai * HALF + m * 16) * ldc + colb;
                *(u32x4*)rowp = odd ? recv : X[0]; *(u32x4*)(rowp + ldc) = odd ? X[1] : recv; }
    }
};
constexpr float F8_SY = 16.0f;
struct EpiPlainF8 {
    unsigned char* O; int ldc; float scale;
    DI void operator()(const f32x4 (&acc)[2][2][4][2], const Unit& u, int wr, int wc, int fr, int fq) const {
        const int odd = fr & 1; const int rowb = u.pm * BM + wr * 64 + (fr - odd), colb = u.pn * BM + wc * 64 + odd * 32 + 8 * fq;
#pragma unroll
        for (int ai = 0; ai < 2; ++ai)
#pragma unroll
            for (int m = 0; m < 4; ++m) { u32x2 X[2];
#pragma unroll
                for (int bj = 0; bj < 2; ++bj) { f32x4 v0 = acc[ai][bj][m][0] * scale, v1 = acc[ai][bj][m][1] * scale;
#pragma unroll
                    for (int j = 0; j < 4; ++j) { v0[j] = f8clamp(v0[j]); v1[j] = f8clamp(v1[j]); }
                    X[bj].x = (unsigned)__builtin_amdgcn_cvt_pk_fp8_f32(v0[0], v0[1], 0, false); X[bj].x = (unsigned)__builtin_amdgcn_cvt_pk_fp8_f32(v0[2], v0[3], (int)X[bj].x, true);
                    X[bj].y = (unsigned)__builtin_amdgcn_cvt_pk_fp8_f32(v1[0], v1[1], 0, false); X[bj].y = (unsigned)__builtin_amdgcn_cvt_pk_fp8_f32(v1[2], v1[3], (int)X[bj].y, true); }
                const u32x2 recv = swap1(odd ? X[0] : X[1]);
                unsigned char* rowp = O + (size_t)(rowb + ai * HALF + m * 16) * ldc + colb;
                *(u32x2*)rowp = odd ? recv : X[0]; *(u32x2*)(rowp + ldc) = odd ? X[1] : recv; }
    }
};
struct EpiRouter {
    float* LOG;
    DI void operator()(const f32x4 (&acc)[2][2][4][2], const Unit& u, int wr, int wc, int fr, int fq) const {
        if (u.pn != 0 || wc >= 2) return;
        const int row0 = u.pm * BM + wr * 64 + fr, col0 = wc * 32 + 4 * fq;
#pragma unroll
        for (int ai = 0; ai < 2; ++ai)
#pragma unroll
            for (int m = 0; m < 4; ++m) { float* rowp = LOG + (size_t)(row0 + ai * HALF + m * 16) * 64 + col0;
#pragma unroll
                for (int n = 0; n < 2; ++n) *(f32x4*)(rowp + n * 16) = acc[ai][0][m][n]; }
    }
};
constexpr float F8_SW13 = 32.0f, F8_SH = 8.0f, F8_SW2 = 64.0f;
struct EpiSwigluF8 {
    unsigned char* H;
    DI void operator()(const f32x4 (&acc)[2][2][4][2], const Unit& u, int wr, int wc, int fr, int fq) const {
        const int row0 = u.pm * BM + wr * 64 + fr, col0 = u.pn * 128 + wc * 32 + 8 * fq;
#pragma unroll
        for (int ai = 0; ai < 2; ++ai)
#pragma unroll
            for (int m = 0; m < 4; ++m) { unsigned char* rowp = H + (size_t)(row0 + ai * HALF + m * 16) * DE + col0; float o[8];
#pragma unroll
                for (int n = 0; n < 2; ++n) { const f32x4 a = acc[ai][0][m][n], b = acc[ai][1][m][n] * (F8_SH / (F8_SW13 * F8_SW13));
#pragma unroll
                    for (int j = 0; j < 4; ++j) o[4 * n + j] = f8clamp(a[j] * b[j] * fast_rcp(1.0f + fast_exp2(a[j] * (-LOG2E / F8_SW13)))); }
                u32x2 w; w.x = (unsigned)__builtin_amdgcn_cvt_pk_fp8_f32(o[0], o[1], 0, false); w.x = (unsigned)__builtin_amdgcn_cvt_pk_fp8_f32(o[2], o[3], (int)w.x, true);
                w.y = (unsigned)__builtin_amdgcn_cvt_pk_fp8_f32(o[4], o[5], 0, false); w.y = (unsigned)__builtin_amdgcn_cvt_pk_fp8_f32(o[6], o[7], (int)w.y, true);
                *(u32x2*)(rowp) = w; }
    }
};
struct EpiInproj {
    bf16_t *U, *Gt, *Q, *Kb, *Vt, *Vtc; const LAS float* rope;
    DI void operator()(const f32x4 (&acc)[2][2][4][2], const Unit& u, int wr, int wc, int fr, int fq) const {
        const int row0 = u.pm * BM + wr * 64 + fr;
        const bool lat = u.pm < (NLAT / BM);
        if (u.pn < 4) {
            bf16_t* base = (u.pn < 2) ? U : Gt; const int odd = fr & 1; const int colb = (u.pn & 1) * 256 + wc * 64 + odd * 32 + 8 * fq;
#pragma unroll
            for (int ai = 0; ai < 2; ++ai)
#pragma unroll
                for (int m = 0; m < 4; ++m) { u32x4 X[2];
#pragma unroll
                    for (int bj = 0; bj < 2; ++bj) { const f32x4 v0 = acc[ai][bj][m][0], v1 = acc[ai][bj][m][1]; X[bj].x = pk2(v0[0], v0[1]); X[bj].y = pk2(v0[2], v0[3]); X[bj].z = pk2(v1[0], v1[1]); X[bj].w = pk2(v1[2], v1[3]); }
                    const u32x4 recv = swap1(odd ? X[0] : X[1]);
                    bf16_t* rowp = base + (size_t)(row0 - odd + ai * HALF + m * 16) * DR + colb;
                    *(u32x4*)rowp = odd ? recv : X[0]; *(u32x4*)(rowp + DR) = odd ? X[1] : recv; }
        } else {
            const bool isq = u.pn < 6;
            const int pq = ((fq & 1) << 1) | (fq >> 1), so = 8 * (fq & 1) + 16 * (fq >> 1);
#define QK_SWAP(a_, b_) asm("s_nop 1\n\tv_permlane32_swap_b32 %0, %1" : "+v"(a_), "+v"(b_))
            const float sc = isq ? 0.125f * LOG2E : 1.0f;
#pragma unroll
            for (int ai = 0; ai < 2; ++ai)
#pragma unroll
                for (int m = 0; m < 4; ++m) {
                    const int r = row0 + ai * HALF + m * 16;
                    f32x4 cs = (f32x4){1.f, 1.f, 1.f, 1.f}, sn = (f32x4){0.f, 0.f, 0.f, 0.f};
                    if (lat) { const int s = r & (SEQ - 1); const int pos = (wc & 1) ? (s & 63) : (s >> 6); cs = *(const LAS f32x4*)(rope + pos * 32 + 4 * pq); sn = *(const LAS f32x4*)(rope + pos * 32 + 16 + 4 * pq); }
                    cs = cs * sc; sn = sn * sc;
                    if (isq) {
                        bf16_t* rowp = Q + (size_t)r * 512 + (u.pn - 4) * 256 + wc * 32 + so;
#pragma unroll
                        for (int bj = 0; bj < 2; ++bj) { const f32x4 x1 = acc[ai][bj][m][0], x2 = acc[ai][bj][m][1]; const f32x4 o1 = x1 * cs - x2 * sn, o2 = x2 * cs + x1 * sn;
                            unsigned ax = pk2(o1[0], o1[1]), ay = pk2(o1[2], o1[3]), bx = pk2(o2[0], o2[1]), by = pk2(o2[2], o2[3]); QK_SWAP(ax, bx); QK_SWAP(ay, by);
                            *(u32x4*)(rowp + bj * HALF) = (u32x4){ax, ay, bx, by}; }
                    } else {
                        { bf16_t* rowp = Kb + (size_t)r * 128 + wc * 32 + so;
                          const f32x4 x1 = acc[ai][0][m][0], x2 = acc[ai][0][m][1]; const f32x4 o1 = x1 * cs - x2 * sn, o2 = x2 * cs + x1 * sn;
                          unsigned ax = pk2(o1[0], o1[1]), ay = pk2(o1[2], o1[3]), bx = pk2(o2[0], o2[1]), by = pk2(o2[2], o2[3]); QK_SWAP(ax, bx); QK_SWAP(ay, by);
                          *(u32x4*)rowp = (u32x4){ax, ay, bx, by}; }
                        const int kvh = wc >> 1; bf16_t* vb; size_t ldv;
                        const int rp = (r & ~15) | (r & 3) | ((r & 4) << 1) | ((r & 8) >> 1);
                        if (lat) { const int b = rp >> 13, s = rp & (SEQ - 1); vb = Vt + ((size_t)(b * 2 + kvh) * 64) * SEQ + s; ldv = SEQ; }
                        else { const int rc = rp - NLAT; const int b = rc >> 8, c = rc & (CL - 1); vb = Vtc + ((size_t)(b * 2 + kvh) * 64) * CL + c; ldv = CL; }
#pragma unroll
                        for (int n = 0; n < 2; ++n)
#pragma unroll
                            for (int j = 0; j < 4; ++j) { const int d = 32 * (wc & 1) + 16 * n + 4 * fq + j; vb[(size_t)d * ldv] = (bf16_t)f2bf(acc[ai][1][m][n][j]); }
                    }
                }
        }
    }
};
}

struct Params { const float* in[29]; float* out; unsigned char* ws; int ph_lo, ph_hi; };
enum { I_X = 0, I_C, I_CTX, I_CCTX, I_WMOD, I_BMOD, I_WIN, I_CONVW, I_CONVB, I_RGWA, I_RGBA, I_RGWX, I_RGBX, I_RGLAM, I_SINK, I_GNR, I_GNA, I_WOUT,
       I_LN1G, I_LN1B, I_RTG, I_RTGB, I_RTE, I_RTEB, I_W1, I_W3, I_W2, I_LN2G, I_LN2B };

typedef const __attribute__((address_space(4))) Params* PP;
DI const float* gin(PP p, int i) { return (const float*)(const GAS float*)p->in[i]; }
struct Ctx {
    LAS unsigned char* lds; int tid, lane, wave, vcu, G, bx; unsigned char* ws; float* out;
};

template <int PERM> DI void p0_transpose_item(const float* W, int K, int N, int k0, int n0, bf16_t* dst0, LAS float* scr, int lane) {
    f32x4 v[8];
#pragma unroll
    for (int i = 0; i < 8; ++i) v[i] = __builtin_nontemporal_load((const f32x4*)(W + (size_t)(k0 + 8 * i + (lane >> 3)) * N + n0 + 4 * (lane & 7)));
#pragma unroll
    for (int i = 0; i < 8; ++i) { LAS float* d = scr + (8 * i + (lane >> 3)) * 33 + 4 * (lane & 7); d[0] = v[i][0]; d[1] = v[i][1]; d[2] = v[i][2]; d[3] = v[i][3]; }
    asm volatile("s_waitcnt lgkmcnt(0)" ::: "memory");
    const int c = lane & 7;
#pragma unroll
    for (int j = 0; j < 4; ++j) { const int n = (lane >> 3) + 8 * j; const LAS float* s = scr + (8 * c) * 33 + n;
        u32x4 o; o.x = pk2(s[0 * 33], s[1 * 33]); o.y = pk2(s[2 * 33], s[3 * 33]); o.z = pk2(s[4 * 33], s[5 * 33]); o.w = pk2(s[6 * 33], s[7 * 33]);
        const int nd = (PERM == 1) ? (16 * ((n >> 2) & 1) + 4 * (n >> 3) + (n & 3)) : (PERM == 2) ? ((n & 19) | ((n & 4) << 1) | ((n & 8) >> 1)) : n;
        *(u32x4*)(dst0 + (size_t)nd * K + k0 + 8 * c) = o; }
    asm volatile("s_waitcnt lgkmcnt(0)" ::: "memory");
}

DI void p0_transpose_item_f8(const float* W, int N, int k0, int n0, unsigned char* dst0, int Kb, float sc, LAS float* scr, int lane) {
    f32x4 v[8];
#pragma unroll
    for (int i = 0; i < 8; ++i) v[i] = __builtin_nontemporal_load((const f32x4*)(W + (size_t)(k0 + 8 * i + (lane >> 3)) * N + n0 + 4 * (lane & 7)));
#pragma unroll
    for (int i = 0; i < 8; ++i) { LAS float* d = scr + (8 * i + (lane >> 3)) * 33 + 4 * (lane & 7); d[0] = v[i][0]; d[1] = v[i][1]; d[2] = v[i][2]; d[3] = v[i][3]; }
    asm volatile("s_waitcnt lgkmcnt(0)" ::: "memory");
    const int c = lane & 3;
#pragma unroll
    for (int j = 0; j < 2; ++j) { const int n = (lane >> 2) + 16 * j; const LAS float* s = scr + (16 * c) * 33 + n; u32x4 o;
#pragma unroll
        for (int q = 0; q < 4; ++q) { int w = __builtin_amdgcn_cvt_pk_fp8_f32(f8clamp(s[(4 * q) * 33] * sc), f8clamp(s[(4 * q + 1) * 33] * sc), 0, false); w = __builtin_amdgcn_cvt_pk_fp8_f32(f8clamp(s[(4 * q + 2) * 33] * sc), f8clamp(s[(4 * q + 3) * 33] * sc), w, true); o[q] = (unsigned)w; }
        const int nd = 16 * ((n >> 2) & 1) + 4 * (n >> 3) + (n & 3);
        *(u32x4*)(dst0 + (size_t)nd * Kb + k0 + 16 * c) = o; }
    asm volatile("s_waitcnt lgkmcnt(0)" ::: "memory");
}

constexpr int MOE_ITEMS = 3 * 32 * 256;
DI void moe_weight_item(const Ctx& F, PP p, int l, int r, LAS float* scr) {
    if (r < 2 * 8192) { const int which = r >> 13; r &= 8191; const int e = r >> 8, kb = (r & 255) >> 4, nb = r & 15; const int n0 = nb * 32;
        const int drow = (n0 >> 7) * 256 + which * 128 + (n0 & 127);
        p0_transpose_item_f8(gin(p, which ? I_W3 : I_W1) + ((size_t)l * NE + e) * 1024 * DE, DE, kb * 64, n0, (unsigned char*)(F.ws + WS_W13) + (((size_t)l * NE + e) * 1024 + drow) * 1024, 1024, pg8::F8_SW13, scr, F.lane); }
    else { r -= 2 * 8192; const int e = r >> 8, kb = (r & 255) >> 5, nb = r & 31;
        p0_transpose_item_f8(gin(p, I_W2) + ((size_t)l * NE + e) * DE * 1024, 1024, kb * 64, nb * 32, (unsigned char*)(F.ws + WS_W2) + (((size_t)l * NE + e) * 1024 + wblk(nb) * 32) * DE, DE, pg8::F8_SW2, scr, F.lane); }
}
DI void bg_moe_weights(const Ctx& F, PP p, int l, int budget) {
    if (l >= DEPTH) return;
    unsigned* q = (unsigned*)(F.ws + WS_CTL) + CW_BGQ + l * 64; LAS float* scr = (LAS float*)(F.lds + F.wave * 16384);
    if (budget < 0) {
        const unsigned head = (unsigned)__builtin_amdgcn_readfirstlane((int)__hip_atomic_load(q, __ATOMIC_RELAXED, __HIP_MEMORY_SCOPE_AGENT));
        for (unsigned idx = head + (unsigned)(F.vcu * 8 + F.wave); idx < (unsigned)MOE_ITEMS; idx += (unsigned)(F.G * 8)) moe_weight_item(F, p, l, (int)idx, scr);
        return; }
    unsigned idx = 0; if (F.lane == 0) idx = __hip_atomic_fetch_add(q, (unsigned)budget, __ATOMIC_RELAXED, __HIP_MEMORY_SCOPE_AGENT);
    idx = (unsigned)__builtin_amdgcn_readfirstlane((int)idx);
    for (int n = 0; n < budget && idx + (unsigned)n < (unsigned)MOE_ITEMS; ++n) moe_weight_item(F, p, l, (int)(idx + (unsigned)n), scr);
}

DI void phase_prologue_a(const Ctx& F, PP p) {
    {
        LAS float* SC = (LAS float*)F.lds;
        LAS float* RED = (LAS float*)(F.lds + 36864);
        for (int i = F.tid; i < 9 * 1024; i += 512) { const int row = i >> 10, k = i & 1023; const float v = row < 8 ? gin(p, I_C)[row * 1024 + k] : gin(p, I_CCTX)[k]; SC[i] = v * sigmoidf_(v); }
        __syncthreads();
        float* MOD = (float*)(F.ws + WS_MOD);
        for (int it = F.vcu; it < 4 * 96; it += F.G) {
            const int l = it / 96, n = (it % 96) * 64 + F.lane;
            const float* wp = gin(p, I_WMOD) + (size_t)l * 1024 * 6144 + (size_t)(F.wave * 128) * 6144 + n;
            float acc[9];
#pragma unroll
            for (int r = 0; r < 9; ++r) acc[r] = 0.f;
            for (int k0 = 0; k0 < 128; k0 += 64) {
                float wv[64];
#pragma unroll
                for (int j = 0; j < 64; ++j) wv[j] = __builtin_nontemporal_load(wp + (size_t)(k0 + j) * 6144);
#pragma unroll
                for (int j = 0; j < 64; ++j)
#pragma unroll
                    for (int r = 0; r < 9; ++r) acc[r] += SC[r * 1024 + F.wave * 128 + k0 + j] * wv[j];
            }
#pragma unroll
            for (int r = 0; r < 9; ++r) RED[(F.wave * 9 + r) * 64 + F.lane] = acc[r];
            __syncthreads();
            for (int i = F.tid; i < 9 * 64; i += 512) { const int r = i >> 6, c = i & 63; float s = 0.f;
#pragma unroll
                for (int w = 0; w < 8; ++w) s += RED[(w * 9 + r) * 64 + c];
                const int nn = (it % 96) * 64 + c; MOD[((size_t)l * 9 + r) * 6144 + nn] = s + gin(p, I_BMOD)[l * 6144 + nn]; }
            __syncthreads();
        }
    }
    if (F.vcu == 0) { float* rope = (float*)(F.ws + WS_ROPE);
        for (int i = F.tid; i < 128 * 16; i += 512) { const int pos = i >> 4, j = i & 15; const float inv = exp2f(-(float)(2 * j) * (13.287712379549449f / 32.0f)); const float ang = (float)pos * inv;
            rope[pos * 32 + j] = cosf(ang); rope[pos * 32 + 16 + j] = sinf(ang); } }
    { bf16_t* WR = (bf16_t*)(F.ws + WS_WR);
      for (int i = F.vcu * 512 + F.tid; i < 4 * 256 * 1024; i += F.G * 512) { const int l = i >> 18, n = (i >> 10) & 255, k = i & 1023; float v = 0.f;
          if (n < 4) v = gin(p, I_RTG)[((size_t)l * 1024 + k) * 4 + n]; else if (n < 36) v = gin(p, I_RTE)[((size_t)l * 1024 + k) * 32 + (n - 4)];
          WR[i] = (bf16_t)f2bf(v); } }
    {
        LAS float* scr = (LAS float*)(F.lds + F.wave * 16384);
        const int gw = F.vcu * 8 + F.wave, NGW = F.G * 8;
        constexpr int I_IN = 16 * 56, I_OUT = 16 * 32, PER_L = I_IN + I_OUT;
        for (int it = gw; it < 4 * PER_L + MOE_ITEMS; it += NGW) {
            if (it >= 4 * PER_L) { moe_weight_item(F, p, 0, it - 4 * PER_L, scr); continue; }
            const int l = it / PER_L; int r = it % PER_L;
            if (r < I_IN) { const int kb = r / 56, nb = r % 56; if (nb < 32) p0_transpose_item<true>(gin(p, I_WIN) + (size_t)l * 1024 * DIN, 1024, DIN, kb * 64, nb * 32, (bf16_t*)(F.ws + WS_WIN) + ((size_t)l * DIN + wblk(nb) * 32) * 1024, scr, F.lane); else if (nb < 52) p0_transpose_item<2>(gin(p, I_WIN) + (size_t)l * 1024 * DIN, 1024, DIN, kb * 64, nb * 32, (bf16_t*)(F.ws + WS_WIN) + ((size_t)l * DIN + nb * 32) * 1024, scr, F.lane); else p0_transpose_item<0>(gin(p, I_WIN) + (size_t)l * 1024 * DIN, 1024, DIN, kb * 64, nb * 32, (bf16_t*)(F.ws + WS_WIN) + ((size_t)l * DIN + nb * 32) * 1024, scr, F.lane); continue; } r -= I_IN;
            { const int kb = r / 32, nb = r % 32; p0_transpose_item<true>(gin(p, I_WOUT) + (size_t)l * 1024 * 1024, 1024, 1024, kb * 64, nb * 32, (bf16_t*)(F.ws + WS_WOUT) + ((size_t)l * 1024 + wblk(nb) * 32) * 1024, scr, F.lane); }
        }
    }
}

DI void router_fold_weights(const Ctx& F, PP p) {
    for (int it = F.vcu * 8 + F.wave; it < 4 * 8 * 36; it += F.G * 8) {
        const int l = it / 288, b = (it / 36) % 8, n = it % 36;
        const float* mod = (const float*)(F.ws + WS_MOD) + ((size_t)l * 9 + b) * 6144; const float* sh2 = mod + 3 * D; const float* sc2 = mod + 4 * D;
        _Float16* wd = (_Float16*)(F.ws + WS_WRB) + ((size_t)(l * 8 + b) * 64 + n) * 1024;
        float sn = 0.f, tn = 0.f;
#pragma unroll 4
        for (int j = 0; j < 16; ++j) { const int k = F.lane + 64 * j;
            const float w = (n < 4) ? gin(p, I_RTG)[((size_t)l * 1024 + k) * 4 + n] : gin(p, I_RTE)[((size_t)l * 1024 + k) * 32 + (n - 4)];
            const _Float16 wf = (_Float16)((1.0f + sc2[k]) * w); wd[k] = wf; sn += (float)wf; tn = __builtin_fmaf(sh2[k], w, tn); }
        sn = wave_sum(sn); tn = wave_sum(tn);
        if (F.lane == 0) { float* SN = (float*)(F.ws + WS_SNT) + (l * 8 + b) * 64 + n; SN[0] = sn; SN[4 * 8 * 64] = tn + ((n < 4) ? gin(p, I_RTGB)[l * 4 + n] : gin(p, I_RTEB)[l * 32 + (n - 4)]); }
    }
}

DI void row_stats(const f32x4 (&v)[4], float& mean, float& rstd) {
    float s = 0.f;
#pragma unroll
    for (int j = 0; j < 4; ++j) s += (v[j][0] + v[j][1]) + (v[j][2] + v[j][3]);
    mean = wave_sum(s) * (1.f / D); float q = 0.f;
#pragma unroll
    for (int j = 0; j < 4; ++j) { const f32x4 d = v[j] - mean; q += (d[0] * d[0] + d[1] * d[1]) + (d[2] * d[2] + d[3] * d[3]); }
    rstd = 1.0f / sqrtf(wave_sum(q) * (1.f / D) + LN_EPS);
}
DI void modulate_store(const f32x4 (&v)[4], const float* sh, const float* sc, bf16_t* orow, int lane) {
    float mean, rstd; row_stats(v, mean, rstd);
#pragma unroll
    for (int j = 0; j < 4; ++j) { const int c = 4 * lane + 256 * j; const f32x4 s1 = *(const f32x4*)(sc + c), s0 = *(const f32x4*)(sh + c);
        const f32x4 h = (v[j] - mean) * rstd * (s1 + 1.0f) + s0; u32x2 w; w.x = pk2(h[0], h[1]); w.y = pk2(h[2], h[3]); *(u32x2*)(orow + c) = w; }
}
DI const float* xrow_in(PP p, const Ctx& F, int l, int r) {
    if (l == 0) return r < NLAT ? gin(p, I_X) + (size_t)r * D : gin(p, I_CTX) + (size_t)(r - NLAT) * D;
    return r < NLAT ? F.out + (size_t)r * D : (const float*)(F.ws + WS_XC) + (size_t)(r - NLAT) * D;
}
DI float* xrow_out(const Ctx& F, int r) { return r < NLAT ? F.out + (size_t)r * D : (float*)(F.ws + WS_XC) + (size_t)(r - NLAT) * D; }

template <int MODE> struct RowBuf { u32x4 x[4]; u32x2 y[4]; u32x2 z[4]; float ga, gb; u32x2 sv; f32x2 gv; };
template <int MODE> DI void rows_slot_load(u32x2& sv, f32x2& gv, const Ctx& F, int r) {
    if (MODE == 2) { sv = *(const u32x2*)((const int*)(F.ws + WS_TOKR) + 2 * (size_t)r); gv = *(const f32x2*)((const float*)(F.ws + WS_TOKG) + 2 * (size_t)r); }
}
template <int MODE, bool SRC16> DI void rows_data_load(RowBuf<MODE>& R, const Ctx& F, PP p, int l, int r, const u32x2 sv, const f32x2 gv) {
    if (SRC16) { const unsigned short* xb = (const unsigned short*)(F.ws + WS_XB) + (size_t)r * D;
#pragma unroll
        for (int j = 0; j < 4; ++j) { const u32x2 t = __builtin_nontemporal_load((const u32x2*)(xb + 4 * F.lane + 256 * j)); R.x[j] = (u32x4){t.x, t.y, 0u, 0u}; }
    } else { const float* x = (MODE == 2) ? (const float*)xrow_out(F, r) : xrow_in(p, F, MODE == 0 ? 0 : l, r);
#pragma unroll
        for (int j = 0; j < 4; ++j) R.x[j] = __builtin_nontemporal_load((const u32x4*)(x + 4 * F.lane + 256 * j)); }
    if (MODE == 1) { const bf16_t* Y = (const bf16_t*)(F.ws + WS_Y) + (size_t)r * D;
#pragma unroll
        for (int j = 0; j < 4; ++j) R.y[j] = __builtin_nontemporal_load((const u32x2*)(Y + 4 * F.lane + 256 * j)); }
    if (MODE == 2) { const unsigned char* YM = F.ws + WS_YMOE; const unsigned char* ya = YM + (size_t)sv.x * D; const unsigned char* yb = YM + (size_t)sv.y * D; R.ga = gv.x * (1.0f / pg8::F8_SY); R.gb = gv.y * (1.0f / pg8::F8_SY);
#pragma unroll
        for (int j = 0; j < 4; ++j) { R.y[j] = (u32x2){__builtin_nontemporal_load((const unsigned*)(ya + 4 * F.lane + 256 * j)), 0u}; R.z[j] = (u32x2){__builtin_nontemporal_load((const unsigned*)(yb + 4 * F.lane + 256 * j)), 0u}; } }
}
struct RowVecs { f32x4 lg[4], lb[4], gg[4], sh[4], sc[4]; };
template <int MODE, bool SRC16, bool ISCTX, bool FEED, bool LASTOUT, bool HOC> DI void row_compute(const Ctx& F, const RowBuf<MODE>& R, const RowVecs& V, const int r, const bool valid, unsigned* ctxin) {
    unsigned char* const DUM = F.ws + WS_DUMMY;
    f32x4 v[4], xv[4];
    if (SRC16) {
#pragma unroll
        for (int j = 0; j < 4; ++j) { const f32x2 a = unpkh2(R.x[j].x), b2 = unpkh2(R.x[j].y); xv[j] = (f32x4){a.x, a.y, b2.x, b2.y}; }
    } else {
#pragma unroll
        for (int j = 0; j < 4; ++j) xv[j] = __builtin_bit_cast(f32x4, R.x[j]);
    }
    if (MODE == 0) {
#pragma unroll
        for (int j = 0; j < 4; ++j) v[j] = xv[j];
    } else {
#pragma unroll
        for (int j = 0; j < 4; ++j) { f32x4 yv;
            if (MODE == 2) { const f32x2 a0 = __builtin_amdgcn_cvt_pk_f32_fp8((int)R.y[j].x, false), a1 = __builtin_amdgcn_cvt_pk_f32_fp8((int)R.y[j].x, true), b0 = __builtin_amdgcn_cvt_pk_f32_fp8((int)R.z[j].x, false), b1 = __builtin_amdgcn_cvt_pk_f32_fp8((int)R.z[j].x, true);
                yv = (f32x4){a0.x, a0.y, a1.x, a1.y} * R.ga + (f32x4){b0.x, b0.y, b1.x, b1.y} * R.gb; }
            else yv = (f32x4){bf_lo(R.y[j].x), bf_hi(R.y[j].x), bf_lo(R.y[j].y), bf_hi(R.y[j].y)};
            v[j] = xv[j] * ALPHA + V.gg[j] * yv; }
        float mean, rstd; row_stats(v, mean, rstd);
#pragma unroll
        for (int j = 0; j < 4; ++j) v[j] = (v[j] - mean) * rstd * V.lg[j] + V.lb[j];
        if (!ISCTX && !LASTOUT) { unsigned short* xb = valid ? (unsigned short*)(F.ws + WS_XB) + (size_t)r * D : (unsigned short*)DUM;
#pragma unroll
            for (int j = 0; j < 4; ++j) { u32x2 w; w.x = pkh2(v[j][0], v[j][1]); w.y = pkh2(v[j][2], v[j][3]); *(u32x2*)(xb + 4 * F.lane + 256 * j) = w; }
        } else { float* xo = valid ? xrow_out(F, r) : (float*)DUM;
#pragma unroll
            for (int j = 0; j < 4; ++j) *(f32x4*)(xo + 4 * F.lane + 256 * j) = v[j]; }
    }
    if (FEED) { float mean, rstd; row_stats(v, mean, rstd);
        if (MODE == 1 && !ISCTX) { float* st = (valid && F.lane == 0) ? (float*)(F.ws + WS_ROWST) + 2 * (size_t)r : (float*)DUM + 2 * F.lane; *(f32x2*)st = (f32x2){mean, rstd}; }
        bf16_t* orow = valid ? (bf16_t*)(F.ws + WS_HA) + (size_t)r * D : (bf16_t*)DUM; unsigned char* o8 = valid ? F.ws + WS_HA8 + (size_t)r * D : DUM;
#pragma unroll
        for (int j = 0; j < 4; ++j) { const f32x4 hh = (v[j] - mean) * rstd * (V.sc[j] + 1.0f) + V.sh[j]; u32x2 w; w.x = pk2(hh[0], hh[1]); w.y = pk2(hh[2], hh[3]);
            if (HOC) __hip_atomic_store((unsigned long long*)(orow + 4 * F.lane + 256 * j), ((unsigned long long)w.y << 32) | w.x, __ATOMIC_RELAXED, __HIP_MEMORY_SCOPE_AGENT);
            else if (MODE != 1 || ISCTX) *(u32x2*)(orow + 4 * F.lane + 256 * j) = w;
            if (MODE == 1) { int q = __builtin_amdgcn_cvt_pk_fp8_f32(f8clamp(hh[0]), f8clamp(hh[1]), 0, false); q = __builtin_amdgcn_cvt_pk_fp8_f32(f8clamp(hh[2]), f8clamp(hh[3]), q, true); *(unsigned*)(o8 + 4 * F.lane + 256 * j) = (unsigned)q; } } }
    if (HOC) { asm volatile("s_waitcnt vmcnt(0)" ::: "memory"); if (F.lane == 0) __hip_atomic_fetch_add(ctxin + ((r - NLAT) >> 8) * 64, 1u, __ATOMIC_RELAXED, __HIP_MEMORY_SCOPE_AGENT); }
}
template <int MODE, bool FEED> DI void rows_load_vecs(RowVecs& V, const Ctx& F, int l, int b) {
    const float* mod = (const float*)(F.ws + WS_MOD) + (size_t)(MODE == 0 ? 0 : l) * 9 * 6144 + (size_t)b * 6144;
    const float* pg = mod + (MODE == 1 ? 2 * D : 5 * D); const float* psh = (MODE == 0) ? mod : (MODE == 1 ? mod + 3 * D : mod + 9 * 6144); const float* psc = (MODE == 0) ? mod + D : (MODE == 1 ? mod + 4 * D : mod + 9 * 6144 + D);
#pragma unroll
    for (int j = 0; j < 4; ++j) { const int c = 4 * F.lane + 256 * j; if (MODE != 0) V.gg[j] = *(const f32x4*)(pg + c);
        if (FEED) { V.sh[j] = *(const f32x4*)(psh + c); V.sc[j] = *(const f32x4*)(psc + c); } }
}
template <int MODE, bool SRC16, bool FEED, bool LASTOUT> DI void rows_run(const Ctx& F, PP p, int l, const int rbase, const int n, RowVecs& V) {
    rows_load_vecs<MODE, FEED>(V, F, l, rbase >> 13);
#define ROW_C(k) (rbase + 8 * ((k) < n ? (k) : n - 1))
    RowBuf<MODE> r0, r1, r2;
    r0.sv = r1.sv = r2.sv = (u32x2){0u, 0u}; r0.gv = r1.gv = r2.gv = (f32x2){0.f, 0.f};
    rows_slot_load<MODE>(r0.sv, r0.gv, F, ROW_C(0)); rows_slot_load<MODE>(r1.sv, r1.gv, F, ROW_C(1)); rows_slot_load<MODE>(r2.sv, r2.gv, F, ROW_C(2));
    rows_data_load<MODE, SRC16>(r0, F, p, l, ROW_C(0), r0.sv, r0.gv); rows_data_load<MODE, SRC16>(r1, F, p, l, ROW_C(1), r1.sv, r1.gv);
    auto step = [&](RowBuf<MODE>& cur, RowBuf<MODE>& ld, const int k) __attribute__((always_inline)) {
        rows_slot_load<MODE>(cur.sv, cur.gv, F, ROW_C(k + 3));
        rows_data_load<MODE, SRC16>(ld, F, p, l, ROW_C(k + 2), ld.sv, ld.gv);
        row_compute<MODE, SRC16, false, FEED, LASTOUT, false>(F, cur, V, ROW_C(k), k < n, nullptr);
    };
    step(r0, r2, 0); step(r1, r0, 1); step(r2, r1, 2);
    int k = 3;
    for (; k + 2 < n; k += 3) { step(r0, r2, k); step(r1, r0, k + 1); step(r2, r1, k + 2); }
    if (k < n) step(r0, r2, k);
    if (k + 1 < n) step(r1, r0, k + 1);
#undef ROW_C
}
template <int MODE, bool HANDOFF> DI void phase_rows(const Ctx& F, PP p, int l, int nrows) {
    constexpr bool FEED = (MODE != 2) || HANDOFF, LASTOUT = (MODE == 2) && !HANDOFF;
    const int gw = F.vcu * 8 + F.wave, NGW = F.G * 8;
    constexpr int PU = (MODE == 0) ? 22 : 23, PO = (MODE == 0) ? 35 : 35;
    static_assert(448 * PU + 1600 * PO >= NLAT, "row split");
    const bool ho = HANDOFF && F.G == 256;
    const int per = ho ? (F.vcu < 56 ? PU : PO) : (NLAT + NGW - 1) / NGW;
    const int lstart = (ho ? (F.vcu < 56 ? F.vcu * 8 * PU : 448 * PU + (F.vcu - 56) * 8 * PO) : F.vcu * 8 * per) + F.wave;
    const int nctx = (nrows > NLAT) ? (nrows - NLAT + NGW - 1) / NGW : 0;
    int nlat = (NLAT - lstart + 7) / 8; nlat = nlat < 0 ? 0 : (nlat > per ? per : nlat);
    unsigned* ctxin = (unsigned*)(F.ws + WS_CTL) + CW_CTXIN + (MODE == 0 ? 0 : l + 1) * 8 * 64;
    RowVecs V;
    if (MODE != 0) { const float* g = gin(p, MODE == 1 ? I_LN1G : I_LN2G) + l * D; const float* bb = gin(p, MODE == 1 ? I_LN1B : I_LN2B) + l * D;
#pragma unroll
        for (int j = 0; j < 4; ++j) { V.lg[j] = *(const f32x4*)(g + 4 * F.lane + 256 * j); V.lb[j] = *(const f32x4*)(bb + 4 * F.lane + 256 * j); } }
    auto ctx_rows = [&]() __attribute__((always_inline)) {
        for (int k = 0; k < nctx; ++k) { const int r = NLAT + gw + k * NGW; if (r >= nrows) break;
            rows_load_vecs<MODE, FEED>(V, F, l, 8);
            RowBuf<MODE> rb; u32x2 sv = (u32x2){0u, 0u}; f32x2 gv = (f32x2){0.f, 0.f}; rows_slot_load<MODE>(sv, gv, F, r); rows_data_load<MODE, false>(rb, F, p, l, r, sv, gv);
            if (ho) row_compute<MODE, false, true, FEED, LASTOUT, HANDOFF>(F, rb, V, r, true, ctxin); else row_compute<MODE, false, true, FEED, LASTOUT, false>(F, rb, V, r, true, ctxin); } };
    if (ho) ctx_rows();
    for (int k0 = 0; k0 < nlat; ) {
        const int rbase = lstart + 8 * k0; const int rend = ((rbase >> 13) + 1) << 13; int n = (rend - rbase + 7) / 8; n = n < nlat - k0 ? n : nlat - k0;
        if (MODE == 2) rows_run<MODE, true, FEED, LASTOUT>(F, p, l, rbase, n, V);
        else if (MODE == 1 && l > 0) rows_run<MODE, MODE == 1, FEED, LASTOUT>(F, p, l, rbase, n, V);
        else rows_run<MODE, false, FEED, LASTOUT>(F, p, l, rbase, n, V);
        k0 += n; }
    if (!ho) ctx_rows();
    if (ho && nctx > 0 && F.vcu < 56) {
        const int tile = F.vcu / 7, pn = F.vcu % 7, ln = (MODE == 0) ? 0 : l + 1;
        __syncthreads();
        if (F.wave == 0) { unsigned* cw = ctxin + tile * 64; unsigned spins = 0;
            while ((unsigned)__builtin_amdgcn_readfirstlane(__hip_atomic_load(cw, __ATOMIC_RELAXED, __HIP_MEMORY_SCOPE_AGENT)) < 256u) { __builtin_amdgcn_s_sleep(4); if (++spins > (1u << 22)) break; }
            __builtin_amdgcn_fence(__ATOMIC_ACQUIRE, "agent"); asm volatile("s_waitcnt vmcnt(0)" ::: "memory"); }
        __syncthreads();
        pg8::OneUnit S; S.pm = NLAT / 256 + tile; S.pn = pn; S.K = 1024;
        pg8::EpiInproj E{(bf16_t*)(F.ws + WS_U), (bf16_t*)(F.ws + WS_G), (bf16_t*)(F.ws + WS_Q), (bf16_t*)(F.ws + WS_KB), (bf16_t*)(F.ws + WS_VT), (bf16_t*)(F.ws + WS_VTC), (const LAS float*)(F.lds + ROPE_OFF)};
        pg8::gemm_phase<pg8::EpiInproj, pg8::OneUnit>(F.lds, F.tid, (const bf16_t*)(F.ws + WS_HA), (const bf16_t*)(F.ws + WS_WIN) + (size_t)ln * DIN * 1024, 1024, S, E);
    }
}
DI void phase_scan(const Ctx& F, PP p, int l) {
    constexpr int XC_OFF = 0, AGG_OFF = 36864, CARRY_OFF = 36864 + 8192;
    const bf16_t* U = (const bf16_t*)(F.ws + WS_U); bf16_t* XV = (bf16_t*)(F.ws + WS_XCV);
    unsigned* cnt = (unsigned*)(F.ws + WS_CTL) + CW_SCANX + l * 64 * 64;
    for (int it = F.vcu; it < 256; it += F.G) {
        const int b = it >> 5, cb = (it >> 2) & 7, qd = it & 3;
        const int ck = F.lane & 7, rsub = F.lane >> 3;
        float w[4][8], bias[8];
#pragma unroll
        for (int j = 0; j < 4; ++j) { const f32x4 wa = *(const f32x4*)(gin(p, I_CONVW) + (l * 4 + j) * DR + cb * 64 + ck * 8), wb = *(const f32x4*)(gin(p, I_CONVW) + (l * 4 + j) * DR + cb * 64 + ck * 8 + 4);
            w[j][0] = wa[0]; w[j][1] = wa[1]; w[j][2] = wa[2]; w[j][3] = wa[3]; w[j][4] = wb[0]; w[j][5] = wb[1]; w[j][6] = wb[2]; w[j][7] = wb[3]; }
        { const f32x4 ba = *(const f32x4*)(gin(p, I_CONVB) + l * DR + cb * 64 + ck * 8), bb = *(const f32x4*)(gin(p, I_CONVB) + l * DR + cb * 64 + ck * 8 + 4);
          bias[0] = ba[0]; bias[1] = ba[1]; bias[2] = ba[2]; bias[3] = ba[3]; bias[4] = bb[0]; bias[5] = bb[1]; bias[6] = bb[2]; bias[7] = bb[3]; }
#define CONV_GEOM(blk_) const int idx0 = 2112 * qd + 32 * (blk_) + 4 * rsub; const bool isctx = idx0 < CL; const int L = isctx ? CL : SEQ; const int pos0 = isctx ? idx0 : idx0 - CL; const int rowbase = isctx ? NLAT + b * CL : b * SEQ;
#define CONV_LOAD(dst, blk_) do { CONV_GEOM(blk_); _Pragma("unroll") for (int k = 0; k < 7; ++k) { int pos = pos0 - 2 + k; const bool ok = pos >= 0 && pos < L; pos = ok ? pos : pos0; \
            const u32x4 t = __builtin_nontemporal_load((const u32x4*)(U + (size_t)(rowbase + pos) * DR + cb * 64 + ck * 8)); dst[k] = ok ? t : (u32x4){0u, 0u, 0u, 0u}; } } while (0)
#define CONV_DO(src, blk_) do { CONV_GEOM(blk_); _Pragma("unroll") for (int i = 0; i < 4; ++i) { float x[8]; \
            _Pragma("unroll") for (int e = 0; e < 8; ++e) x[e] = bias[e]; \
            _Pragma("unroll") for (int j = 0; j < 4; ++j) _Pragma("unroll") for (int e = 0; e < 4; ++e) { x[2 * e] = __builtin_fmaf(w[j][2 * e], bf_lo(src[i + j][e]), x[2 * e]); x[2 * e + 1] = __builtin_fmaf(w[j][2 * e + 1], bf_hi(src[i + j][e]), x[2 * e + 1]); } \
            u32x4 o; o.x = pk2(x[0], x[1]); o.y = pk2(x[2], x[3]); o.z = pk2(x[4], x[5]); o.w = pk2(x[6], x[7]); \
            *(u32x4*)(XV + (size_t)(rowbase + pos0 + i) * DR + cb * 64 + ck * 8) = o; } } while (0)
        u32x4 ua[7], ub[7];
        CONV_LOAD(ua, F.wave);
        for (int blk = F.wave; blk < 66; blk += 16) {
            { const int bn = blk + 8 < 66 ? blk + 8 : blk; CONV_LOAD(ub, bn); }
            CONV_DO(ua, blk);
            { const int bn = blk + 16 < 66 ? blk + 16 : blk; CONV_LOAD(ua, bn); }
            if (blk + 8 < 66) CONV_DO(ub, blk + 8);
        }
#undef CONV_DO
#undef CONV_GEOM
#undef CONV_LOAD
    }
    asm volatile("s_waitcnt vmcnt(0)" ::: "memory"); __syncthreads();
    if (F.tid == 0) { __builtin_amdgcn_fence(__ATOMIC_RELEASE, "agent");
        for (int it = F.vcu; it < 256; it += F.G) __hip_atomic_fetch_add(cnt + (it >> 2) * 64, 1u, __ATOMIC_RELAXED, __HIP_MEMORY_SCOPE_AGENT); }
    const int c = F.lane & 31, h = F.lane >> 5, hw = 2 * F.wave + h;
    for (int it = F.vcu; it < 256; it += F.G) {
        const int b = it >> 5, cb = (it >> 2) & 7, dir = (it >> 1) & 1, half = it & 1;
        const int oc = cb * 64 + 32 * half + c;
        bf16_t* OUT = (bf16_t*)(F.ws + (dir ? WS_HB : WS_HF));
        if (F.wave == 0) { unsigned* cw = cnt + (it >> 2) * 64; unsigned spins = 0;
            while ((unsigned)__builtin_amdgcn_readfirstlane(__hip_atomic_load(cw, __ATOMIC_RELAXED, __HIP_MEMORY_SCOPE_AGENT)) < 4u) { __builtin_amdgcn_s_sleep(2); if (++spins > (1u << 22)) break; }
            __builtin_amdgcn_fence(__ATOMIC_ACQUIRE, "agent"); }
        __syncthreads();
        bf16x8 Bwa[4], Bwx[4];
        { const float* wa = gin(p, I_RGWA) + ((size_t)((l * 2 + dir) * 8 + cb) * 64) * 64 + 32 * half + c;
          const float* wx = gin(p, I_RGWX) + ((size_t)((l * 2 + dir) * 8 + cb) * 64) * 64 + 32 * half + c;
#pragma unroll
          for (int s = 0; s < 4; ++s) { u32x4 a, x;
#pragma unroll
              for (int j = 0; j < 4; ++j) { const int i0 = 16 * s + 8 * h + 2 * j; a[j] = pk2(-LOG2E * wa[(size_t)i0 * 64], -LOG2E * wa[(size_t)(i0 + 1) * 64]); x[j] = pk2(-LOG2E * wx[(size_t)i0 * 64], -LOG2E * wx[(size_t)(i0 + 1) * 64]); }
              Bwa[s] = __builtin_bit_cast(bf16x8, a); Bwx[s] = __builtin_bit_cast(bf16x8, x); } }
        const float ba = -LOG2E * gin(p, I_RGBA)[(l * 2 + dir) * DR + oc], bx = -LOG2E * gin(p, I_RGBX)[(l * 2 + dir) * DR + oc];
        float c8;
        { const float lam = gin(p, I_RGLAM)[(l * 2 + dir) * DR + oc]; const float e = __expf(-lam);
          const float sp = (e < 0.03f) ? e * (1.0f - e * (0.5f - e * (0.33333333f - 0.25f * e))) : __logf(1.0f + e); c8 = -8.0f * sp; }
        const float c8l = c8 * LOG2E;
        LAS unsigned char* XCw = F.lds + XC_OFF + F.wave * 4608;
        LAS float* CARRY = (LAS float*)(F.lds + CARRY_OFF);
        const int tokr = 16 * ((c >> 2) & 1) + (c & 3) + 4 * (c >> 3);
        u32x4 pre[4];
#define SCAN_GEOM(sc_) const bool isctx_ = ((sc_) == 0); const int L_ = isctx_ ? CL : SEQ; const int tau0_ = isctx_ ? 0 : 256 * ((sc_) - 1); \
        const int plo_ = dir ? L_ - tau0_ - 256 : tau0_; const int rowbase_ = isctx_ ? NLAT + b * CL : b * SEQ;
#define SCAN_LOAD(sc_) do { SCAN_GEOM(sc_); _Pragma("unroll") for (int k = 0; k < 4; ++k) { const int q = F.lane + 64 * k, j = q >> 3, ck = q & 7; const int st = 32 * F.wave + j; \
            const int pos = dir ? plo_ + 255 - st : plo_ + st; pre[k] = *(const u32x4*)(XV + (size_t)(rowbase_ + pos) * DR + cb * 64 + ck * 8); } } while (0)
        SCAN_LOAD(0);
        for (int sc = 0; sc < 33; ++sc) {
            SCAN_GEOM(sc); const int p_lo = plo_, rowbase = rowbase_;
            LAS f32x2* AGG = (LAS f32x2*)(F.lds + AGG_OFF + (sc & 1) * 4096);
#pragma unroll
            for (int k = 0; k < 4; ++k) { const int q = F.lane + 64 * k; *(LAS u32x4*)(XCw + (q >> 3) * 144 + (q & 7) * 16) = pre[k]; }
            if (sc + 1 < 33) SCAN_LOAD(sc + 1);
            asm volatile("s_waitcnt lgkmcnt(0)" ::: "memory");
            float xo[16];
#pragma unroll
            for (int i = 0; i < 16; ++i) xo[i] = bf2f(*(const LAS bf16_t*)(XCw + (16 * h + i) * 144 + 2 * (32 * half + c)));
            f32x16 Da, Dx;
#pragma unroll
            for (int i = 0; i < 16; ++i) { Da[i] = ba; Dx[i] = bx; }
#pragma unroll
            for (int s = 0; s < 4; ++s) { const bf16x8 Af = *(const LAS bf16x8*)(XCw + tokr * 144 + 32 * s + 16 * h);
                Da = __builtin_amdgcn_mfma_f32_32x32x16_bf16(Af, Bwa[s], Da, 0, 0, 0); Dx = __builtin_amdgcn_mfma_f32_32x32x16_bf16(Af, Bwx[s], Dx, 0, 0, 0); }
            float H[16], PP[16]; float hloc = 0.f, P = 1.f;
#pragma unroll
            for (int i = 0; i < 16; ++i) {
                const float r = fast_rcp(1.0f + fast_exp2(Da[i])), gi = fast_rcp(1.0f + fast_exp2(Dx[i]));
                const float a = fast_exp2(c8l * r);
                const float om = __builtin_fmaf(-a, a, 1.0f);
                const float bb = __builtin_amdgcn_sqrtf(om) * gi * xo[i];
                hloc = __builtin_fmaf(a, hloc, bb); P *= a; H[i] = hloc; PP[i] = P; }
            AGG[hw * 32 + c] = (f32x2){P, hloc};
            lds_barrier();
            float cin = CARRY[(sc & 1) * 32 + c]; f32x2 agv[15];
#pragma unroll
            for (int k = 0; k < 15; ++k) agv[k] = AGG[k * 32 + c];
            __builtin_amdgcn_sched_barrier(0);
            cin = (sc == 0) ? 0.f : cin;
#pragma unroll
            for (int k = 0; k < 15; ++k) { const float nc = agv[k].x * cin + agv[k].y; cin = (k < hw) ? nc : cin; }
            if (hw == 15) CARRY[((sc + 1) & 1) * 32 + c] = P * cin + hloc;
#pragma unroll
            for (int i = 0; i < 16; i += 2) { const float hv0 = __builtin_fmaf(PP[i], cin, H[i]), hv1 = __builtin_fmaf(PP[i + 1], cin, H[i + 1]);
                const unsigned pk = dir ? pk2(hv1, hv0) : pk2(hv0, hv1);
                const int pe = dir ? p_lo + 254 - (16 * hw + i) : p_lo + 16 * hw + i;
                unsigned* ob = (unsigned*)OUT + ((size_t)(cb * 2 + half) * (NT / 2) + (size_t)(rowbase >> 1)) * 32;
                ob[(unsigned)((pe >> 1) * 32 + c)] = pk; }
        }
#undef SCAN_GEOM
#undef SCAN_LOAD
        __syncthreads();
    }
}

DI int crow16(int i, int h) { return (i & 3) + 8 * (i >> 2) + 4 * h; }
DI bf16x8 pack8(const f32x16& x, int s) { u32x4 q; q.x = pk2(x[8 * s], x[8 * s + 1]); q.y = pk2(x[8 * s + 2], x[8 * s + 3]); q.z = pk2(x[8 * s + 4], x[8 * s + 5]); q.w = pk2(x[8 * s + 6], x[8 * s + 7]); return __builtin_bit_cast(bf16x8, q); }
#define ATT_DEAD(qb, kb) ((MM == 1 && (qb) == 1 && (kb) == 0) || (MM == 2 && (qb) == 0 && (kb) == 1))
constexpr float ATT_THR = 6.0f;
template <int MM, int QB> DI void att_st(f32x16 (&St)[2], const LAS unsigned char* Kl, const bf16x8 (&Qf)[2][4], const float (&mrun)[2], const int c, const int h) {
    const float m0 = -mrun[QB];
#pragma unroll
    for (int kb = 0; kb < 2; ++kb)
#pragma unroll
        for (int i = 0; i < 16; ++i) St[kb][i] = m0;
    constexpr int NKB = (ATT_DEAD(QB, 0) ? 0 : 1) + (ATT_DEAD(QB, 1) ? 0 : 1), KB0 = ATT_DEAD(QB, 0) ? 1 : 0, NF = 4 * NKB;
#define ATT_KF(i_) (*(const LAS bf16x8*)(Kl + (32 * (NKB == 2 ? ((i_) & 1) : KB0) + c) * 144 + 32 * (NKB == 2 ? ((i_) >> 1) : (i_)) + 16 * h))
    bf16x8 Kw[3]; Kw[0] = ATT_KF(0); Kw[1] = ATT_KF(1);
#pragma unroll
    for (int i = 0; i < NF; ++i) { const int kb = (NKB == 2) ? (i & 1) : KB0, s = (NKB == 2) ? (i >> 1) : i;
        if (i + 2 < NF) Kw[(i + 2) % 3] = ATT_KF(i + 2);
        St[kb] = __builtin_amdgcn_mfma_f32_32x32x16_bf16(Kw[i % 3], Qf[QB][s], St[kb], 0, 0, 0); }
    if (QB == 0 && NF >= 2) {
        __builtin_amdgcn_sched_group_barrier(0x100, 2, 0);
#pragma unroll
        for (int i = 0; i < NF - 2; ++i) { __builtin_amdgcn_sched_group_barrier(0x008, 1, 0); __builtin_amdgcn_sched_group_barrier(0x100, 1, 0); }
        __builtin_amdgcn_sched_group_barrier(0x008, 2, 0); }
#undef ATT_KF
}
template <int MM, int QB> DI void att_softmax(f32x16 (&St)[2], bf16x8 (&Pf)[2][2], f32x16 (&O)[2][2], float (&mrun)[2], float (&lsum)[2], const int c, const int h) {
    if (MM != 0) {
#pragma unroll
        for (int kb = 0; kb < 2; ++kb) {
            if (ATT_DEAD(QB, kb)) {
#pragma unroll
                for (int i = 0; i < 16; ++i) St[kb][i] = -1.0e30f;
            } else if (kb == QB) {
#pragma unroll
                for (int i = 0; i < 16; ++i) { const int kr = crow16(i, h); const bool bad = (MM == 1) ? (c > kr) : (kr > c); St[kb][i] = bad ? -1.0e30f : St[kb][i]; }
            } }
    }
    float tmax = -3.0e38f;
#pragma unroll
    for (int kb = 0; kb < 2; ++kb)
#pragma unroll
        for (int i = 0; i < 16; ++i) tmax = fmaxf(tmax, St[kb][i]);
    tmax = xor32_max(tmax);
    if (__builtin_amdgcn_ballot_w64(tmax > ATT_THR) != 0ull) {
        const float d = fmaxf(tmax, 0.f); const float alpha = fast_exp2(-d); mrun[QB] += d; lsum[QB] *= alpha;
#pragma unroll
        for (int kb = 0; kb < 2; ++kb)
#pragma unroll
            for (int i = 0; i < 16; ++i) St[kb][i] -= d;
#pragma unroll
        for (int db = 0; db < 2; ++db)
#pragma unroll
            for (int i = 0; i < 16; ++i) O[db][QB][i] *= alpha;
    }
    float ps = 0.f;
#pragma unroll
    for (int kb = 0; kb < 2; ++kb) {
#pragma unroll
        for (int i = 0; i < 16; ++i) { const float pv = fast_exp2(St[kb][i]); St[kb][i] = pv; ps += pv; }
        Pf[kb][0] = pack8(St[kb], 0); Pf[kb][1] = pack8(St[kb], 1); }
    lsum[QB] += ps;
}
template <int MM, int QB> DI void att_pv(const bf16x8 (&Pf)[2][2], f32x16 (&O)[2][2], const LAS unsigned char* Vl, const int c, const int h) {
    constexpr int NKB = (ATT_DEAD(QB, 0) ? 0 : 1) + (ATT_DEAD(QB, 1) ? 0 : 1), KB0 = ATT_DEAD(QB, 0) ? 1 : 0, NF = 4 * NKB;
#define ATT_VF(i_) (*(const LAS bf16x8*)(Vl + (32 * ((i_) & 1) + c) * 144 + (32 * (NKB == 2 ? ((i_) >> 2) : KB0) + 16 * (((i_) >> 1) & 1) + 8 * h) * 2))
    bf16x8 Vw[3]; Vw[0] = ATT_VF(0); Vw[1] = ATT_VF(1);
#pragma unroll
    for (int i = 0; i < NF; ++i) { const int db = i & 1, s2 = (i >> 1) & 1, kb = (NKB == 2) ? (i >> 2) : KB0;
        if (i + 2 < NF) Vw[(i + 2) % 3] = ATT_VF(i + 2);
        O[db][QB] = __builtin_amdgcn_mfma_f32_32x32x16_bf16(Vw[i % 3], Pf[kb][s2], O[db][QB], 0, 0, 0); }
    if (QB == 1 && NF >= 2) {
        __builtin_amdgcn_sched_group_barrier(0x100, 2, 0);
#pragma unroll
        for (int i = 0; i < NF - 2; ++i) { __builtin_amdgcn_sched_group_barrier(0x008, 1, 0); __builtin_amdgcn_sched_group_barrier(0x100, 1, 0); }
        __builtin_amdgcn_sched_group_barrier(0x008, 2, 0); }
#undef ATT_VF
}
template <int MM> DI void att_tile(const LAS unsigned char* Kl, const LAS unsigned char* Vl, const bf16x8 (&Qf)[2][4], f32x16 (&O)[2][2], float (&mrun)[2], float (&lsum)[2], const int c, const int h) {
    f32x16 St0[2], St1[2]; bf16x8 Pf0[2][2], Pf1[2][2];
    __builtin_amdgcn_sched_barrier(0);
    att_st<MM, 0>(St0, Kl, Qf, mrun, c, h);
    __builtin_amdgcn_sched_barrier(0);
    att_st<MM, 1>(St1, Kl, Qf, mrun, c, h);
    att_softmax<MM, 0>(St0, Pf0, O, mrun, lsum, c, h);
    __builtin_amdgcn_sched_barrier(0);
    att_pv<MM, 0>(Pf0, O, Vl, c, h);
    att_softmax<MM, 1>(St1, Pf1, O, mrun, lsum, c, h);
    __builtin_amdgcn_sched_barrier(0);
    att_pv<MM, 1>(Pf1, O, Vl, c, h);
    __builtin_amdgcn_sched_barrier(0);
}
#undef ATT_DEAD
DI void phase_attn(const Ctx& F, PP p, int l) {
    constexpr int STG = 36864, V_OFF = 18432, SS_OFF = 3 * 36864;
    const bf16_t* Q = (const bf16_t*)(F.ws + WS_Q); const bf16_t* Kb = (const bf16_t*)(F.ws + WS_KB); const bf16_t* Vt = (const bf16_t*)(F.ws + WS_VT); const bf16_t* Vtc = (const bf16_t*)(F.ws + WS_VTC);
    const bf16_t* HF = (const bf16_t*)(F.ws + WS_HF); const bf16_t* HB = (const bf16_t*)(F.ws + WS_HB); const bf16_t* Gt = (const bf16_t*)(F.ws + WS_G); bf16_t* HA = (bf16_t*)(F.ws + WS_HA);
    const int nitems = 1024 + ((l < DEPTH - 1) ? 32 : 0);
    const int head = F.wave, kvh = F.wave >> 2;
    const float* gna = gin(p, I_GNA) + l * 512 + head * 64; const float* gnr = gin(p, I_GNR) + l * 512;
    LAS float* SS = (LAS float*)(F.lds + SS_OFF);
    unsigned* ctxcnt = (unsigned*)(F.ws + WS_CTL) + CW_CTXMIX + l * 8 * 64;
    const bool hasctx = nitems > 1024;
    for (int k2 = 0; k2 < 10; ++k2) {
        const bool do_attn = (((k2 ^ F.vcu) & 1) == 0);
        int it;
        if ((k2 >> 1) == 0) { const int v = F.vcu; if (!hasctx) continue; if (do_attn) { if (v >= 32) continue; it = 1024 + v; } else { if (v < 32 || v >= 64) continue; it = 1024 + (v - 32); } }
        else { it = F.vcu + ((k2 >> 1) - 1) * F.G; if (it >= 1024) continue; }
      if (do_attn) {
        const int ti = F.wave * 64 + lane_id_v();
        const int lane_i = ti & 63, c = ti & 31, h = (ti >> 5) & 1;
        const bool islat = it < 1024; int b, q0 = 0, rowbase, kk_lo = 0, nb = 0;
        if (islat) { b = it >> 7; q0 = (it & 127) * 64; rowbase = b * SEQ + q0; kk_lo = -(q0 >> 6); if (kk_lo < -2) kk_lo = -2; int kk_hi = (SEQ - 64 - q0) >> 6; if (kk_hi > 2) kk_hi = 2; nb = kk_hi - kk_lo + 1; }
        else { const int ci = it - 1024; b = ci >> 2; rowbase = NLAT + b * CL + (ci & 3) * 64; }
        const int ntile = nb + 4;
        bf16x8 Qf[2][4];
#pragma unroll
        for (int qb = 0; qb < 2; ++qb)
#pragma unroll
            for (int s = 0; s < 4; ++s) Qf[qb][s] = __builtin_nontemporal_load((const bf16x8*)(Q + (size_t)(rowbase + 32 * qb + c) * 512 + head * 64 + 16 * s + 8 * h));
        const float sink2 = gin(p, I_SINK)[l * 8 + head] * LOG2E;
        float mrun[2] = {sink2, sink2}, lsum[2]; lsum[0] = lsum[1] = (h == 0) ? 1.0f : 0.0f;
        asm volatile("" ::: "memory");
        f32x16 O[2][2];
#pragma unroll
        for (int db = 0; db < 2; ++db)
#pragma unroll
            for (int qb = 0; qb < 2; ++qb)
#pragma unroll
                for (int i = 0; i < 16; ++i) O[db][qb][i] = 0.f;
#define ATT_SRC(j, krow0, vbase, ldv, mode) int krow0; const bf16_t* vbase; int ldv; int mode = 0; \
        if ((j) < nb) { const int kk = kk_lo + (j); const int k0 = q0 + 64 * kk; krow0 = b * SEQ + k0; vbase = Vt + (size_t)(b * 128) * SEQ + k0; ldv = SEQ; mode = (kk == -2) ? 1 : ((kk == 2) ? 2 : 0); } \
        else { const int cx = (j) - nb; krow0 = NLAT + b * CL + 64 * cx; vbase = Vtc + (size_t)(b * 128) * CL + 64 * cx; ldv = CL; }
#define ATT_DMA(buf, krow0, vbase, ldv) do { int ln_ = lane_i; asm volatile("" : "+v"(ln_)); _Pragma("unroll") for (int t_ = 0; t_ < 5; ++t_) { const int in_ = F.wave + 8 * t_; if (in_ < 36) { const bf16_t* g_; \
            if (in_ < 18) { const int q_ = in_ * 64 + ln_; const int kvh_ = q_ / 576, rem_ = q_ - kvh_ * 576, key_ = rem_ / 9, col_ = rem_ - key_ * 9; g_ = Kb + (size_t)((krow0) + key_) * 128 + kvh_ * 64 + (col_ & 7) * 8; } \
            else { const int q_ = (in_ - 18) * 64 + ln_; const int row_ = q_ / 9, col_ = q_ - row_ * 9; g_ = (vbase) + (size_t)row_ * (ldv) + (col_ & 7) * 8; } \
            __builtin_amdgcn_global_load_lds((const unsigned*)g_, (LAS unsigned*)(F.lds + (buf) * STG + in_ * 1024), 16, 0, 0); } } } while (0)
#define ATT_WAITN(has) do { if (has) { if (F.wave < 4) asm volatile("s_waitcnt vmcnt(5)" ::: "memory"); else asm volatile("s_waitcnt vmcnt(4)" ::: "memory"); } else asm volatile("s_waitcnt vmcnt(0)" ::: "memory"); } while (0)
        { ATT_SRC(0, krow0, vbase, ldv, mode0); (void)mode0; ATT_DMA(0, krow0, vbase, ldv); }
        if (ntile > 1) { ATT_SRC(1, krow1, vbase1, ldv1, mode1); (void)mode1; ATT_DMA(1, krow1, vbase1, ldv1); }
        ATT_WAITN(ntile > 1); lds_barrier();
        for (int j = 0; j < ntile; ++j) {
            asm volatile("; ATT_TILE_BEGIN");
            ATT_SRC(j, krow_c, vbase_c, ldv_c, mode); (void)krow_c; (void)vbase_c; (void)ldv_c;
            const int jb = j % 3;
            if (j + 2 < ntile) { ATT_SRC(j + 2, krow_n, vbase_n, ldv_n, mode_n); (void)mode_n; const int nbuf = (j + 2) % 3; ATT_DMA(nbuf, krow_n, vbase_n, ldv_n); }
            const LAS unsigned char* Kl = F.lds + jb * STG + kvh * 64 * 144;
            const LAS unsigned char* Vl = F.lds + jb * STG + V_OFF + kvh * 64 * 144;
            if (mode == 0) att_tile<0>(Kl, Vl, Qf, O, mrun, lsum, c, h); else if (mode == 1) att_tile<1>(Kl, Vl, Qf, O, mrun, lsum, c, h); else att_tile<2>(Kl, Vl, Qf, O, mrun, lsum, c, h);
            asm volatile("; ATT_TILE_END");
            ATT_WAITN(j + 2 < ntile); lds_barrier();
        }
        asm volatile("; ATT_EPI"); const int tz = F.wave * 64 + lane_id_v();
        const int c2 = tz & 31, h2 = (tz >> 5) & 1, lane2 = tz & 63, wave2 = __builtin_amdgcn_readfirstlane(tz >> 6);
#undef ATT_SRC
#undef ATT_DMA
#undef ATT_WAITN
        const float* gna2 = gin(p, I_GNA) + l * 512 + wave2 * 64;
        float ssq[2];
#pragma unroll
        for (int qb = 0; qb < 2; ++qb) { const float lt = xor32_sum(lsum[qb]); const float inv = 1.0f / lt; float s = 0.f;
#pragma unroll
            for (int db = 0; db < 2; ++db)
#pragma unroll
                for (int i = 0; i < 16; ++i) { O[db][qb][i] *= inv; s += O[db][qb][i] * O[db][qb][i]; }
            s = xor32_sum(s); ssq[qb] = s; if (h2 == 0) SS[wave2 * 64 + 32 * qb + c2] = s; }
        __syncthreads();
#pragma unroll
        for (int qb = 0; qb < 2; ++qb) { float tot = 0.f;
#pragma unroll
            for (int w = 0; w < 8; ++w) tot += SS[w * 64 + 32 * qb + c2];
            const float rstd = 1.0f / sqrtf(tot * (1.0f / 512.0f) + LN_EPS);
            bf16_t* orow = HA + (size_t)(rowbase + 32 * qb + c2) * D + 512 + wave2 * 64;
#pragma unroll
            for (int db = 0; db < 2; ++db) { u32x2 w[4];
#pragma unroll
                for (int g = 0; g < 4; ++g) { const int d0 = 32 * db + 8 * g + 4 * h2; const f32x4 gv = *(const f32x4*)(gna2 + d0);
                    w[g].x = pk2(O[db][qb][4 * g] * rstd * gv[0], O[db][qb][4 * g + 1] * rstd * gv[1]); w[g].y = pk2(O[db][qb][4 * g + 2] * rstd * gv[2], O[db][qb][4 * g + 3] * rstd * gv[3]); }
                if (islat) {
#pragma unroll
                    for (int q = 0; q < 2; ++q) { asm("s_nop 1\n\tv_permlane32_swap_b32 %0, %1" : "+v"(w[q].x), "+v"(w[q + 2].x)); asm("s_nop 1\n\tv_permlane32_swap_b32 %0, %1" : "+v"(w[q].y), "+v"(w[q + 2].y)); }
                    bf16_t* dst = orow + 32 * db + 16 * h2;
                    *(u32x4*)dst = (u32x4){w[0].x, w[0].y, w[2].x, w[2].y}; *(u32x4*)(dst + 8) = (u32x4){w[1].x, w[1].y, w[3].x, w[3].y};
                } else {
#pragma unroll
                    for (int g = 0; g < 4; ++g) { const int d0 = 32 * db + 8 * g + 4 * h2;
                        __hip_atomic_store((unsigned long long*)(orow + d0), ((unsigned long long)w[g].y << 32) | w[g].x, __ATOMIC_RELAXED, __HIP_MEMORY_SCOPE_AGENT); } } } }
        if (!islat) { asm volatile("s_waitcnt vmcnt(0)" ::: "memory"); __syncthreads(); if (F.tid == 0) __hip_atomic_fetch_add(ctxcnt + ((it - 1024) >> 2) * 64, 1u, __ATOMIC_RELAXED, __HIP_MEMORY_SCOPE_AGENT); }
      } else {
        int rowbase; if (it < 1024) rowbase = (it >> 7) * SEQ + (it & 127) * 64; else { const int ci = it - 1024; rowbase = NLAT + (ci >> 2) * CL + (ci & 3) * 64; }
        const int tz3 = F.wave * 64 + lane_id_v(); const int lane2 = tz3 & 63, wave2 = __builtin_amdgcn_readfirstlane(tz3 >> 6);
        { u32x4 ha[4][2], hb[4][2], hg[8];
          const int gq = lane2 >> 2, cc0 = 8 * (lane2 & 3);
#pragma unroll
          for (int j = 0; j < 4; ++j) { const size_t rp = (size_t)((rowbase + 8 * wave2) >> 1) + j; const size_t eo = (((size_t)gq * (NT / 2) + rp) * 32 + cc0) * 2;
              ha[j][0] = __builtin_nontemporal_load((const u32x4*)(HF + eo)); ha[j][1] = __builtin_nontemporal_load((const u32x4*)(HF + eo + 8)); hb[j][0] = __builtin_nontemporal_load((const u32x4*)(HB + eo)); hb[j][1] = __builtin_nontemporal_load((const u32x4*)(HB + eo + 8)); }
#pragma unroll
          for (int t = 0; t < 8; ++t) { const size_t row = (size_t)(rowbase + 8 * wave2 + t); hg[t] = __builtin_nontemporal_load((const u32x4*)(Gt + row * DR + 8 * lane2)); }
          const f32x4 g0 = *(const f32x4*)(gnr + 8 * lane2), g1 = *(const f32x4*)(gnr + 8 * lane2 + 4);
#pragma unroll
          for (int t = 0; t < 8; ++t) { const size_t row = (size_t)(rowbase + 8 * wave2 + t);
              float mv[8]; float s = 0.f;
#pragma unroll
              for (int k = 0; k < 8; ++k) { const unsigned wa = ha[t >> 1][k >> 2][k & 3], wb = hb[t >> 1][k >> 2][k & 3], wg = hg[t][k >> 1];
                  const float hsum = (t & 1) ? bf_hi(wa) + bf_hi(wb) : bf_lo(wa) + bf_lo(wb); const float gk = (k & 1) ? bf_hi(wg) : bf_lo(wg);
                  mv[k] = hsum * gelu_tanh(gk); s += mv[k] * mv[k]; }
              s = wave_sum(s); const float rstd = 1.0f / sqrtf(s * (1.0f / 512.0f) + LN_EPS);
              u32x4 o; o.x = pk2(mv[0] * rstd * g0[0], mv[1] * rstd * g0[1]); o.y = pk2(mv[2] * rstd * g0[2], mv[3] * rstd * g0[3]); o.z = pk2(mv[4] * rstd * g1[0], mv[5] * rstd * g1[1]); o.w = pk2(mv[6] * rstd * g1[2], mv[7] * rstd * g1[3]);
              if (it < 1024) *(u32x4*)(HA + row * D + 8 * lane2) = o;
              else { unsigned long long* d8 = (unsigned long long*)(HA + row * D + 8 * lane2); __hip_atomic_store(d8, ((unsigned long long)o.y << 32) | o.x, __ATOMIC_RELAXED, __HIP_MEMORY_SCOPE_AGENT); __hip_atomic_store(d8 + 1, ((unsigned long long)o.w << 32) | o.z, __ATOMIC_RELAXED, __HIP_MEMORY_SCOPE_AGENT); } } }
        if (it >= 1024) { asm volatile("s_waitcnt vmcnt(0)" ::: "memory"); __syncthreads(); if (F.tid == 0) __hip_atomic_fetch_add(ctxcnt + ((it - 1024) >> 2) * 64, 1u, __ATOMIC_RELAXED, __HIP_MEMORY_SCOPE_AGENT); }
      }
    }
    if (hasctx && F.G == 256 && F.vcu >= 64 && F.vcu < 96) {
        const int j = F.vcu - 64, tile = j >> 2;
        __syncthreads();
        if (F.wave == 0) { unsigned* cw = ctxcnt + tile * 64; unsigned spins = 0;
            while ((unsigned)__builtin_amdgcn_readfirstlane(__hip_atomic_load(cw, __ATOMIC_RELAXED, __HIP_MEMORY_SCOPE_AGENT)) < 8u) { __builtin_amdgcn_s_sleep(4); if (++spins > (1u << 22)) break; }
            __builtin_amdgcn_fence(__ATOMIC_ACQUIRE, "agent"); asm volatile("s_waitcnt vmcnt(0)" ::: "memory"); }
        __syncthreads();
        pg8::OneUnit S; S.pm = NLAT / 256 + tile; S.pn = j & 3; S.K = 1024;
        pg8::EpiPlainBf16 E{(bf16_t*)(F.ws + WS_Y), D, 1.0f};
        pg8::gemm_phase<pg8::EpiPlainBf16, pg8::OneUnit>(F.lds, F.tid, (const bf16_t*)(F.ws + WS_HA), (const bf16_t*)(F.ws + WS_WOUT) + (size_t)l * 1024 * 1024, 1024, S, E);
    }
    if (F.G == 256 && hasctx && F.vcu >= 96) bg_moe_weights(F, p, l + 1, 7);
}

DI void route_block(const Ctx& F, PP p, int l, int row0, int crow0) {
    LAS int* lcnt = (LAS int*)F.lds; LAS int* lbase = lcnt + 32;
    const float* LOG = (const float*)(F.ws + WS_LOG); int* TE = (int*)(F.ws + WS_TOKE); int* TR = (int*)(F.ws + WS_TOKR); float* TG = (float*)(F.ws + WS_TOKG);
    unsigned* gcnt = (unsigned*)(F.ws + WS_CTL) + CW_ECNT + l * 64;
    const float* gb = gin(p, I_RTGB) + l * 4; const float* eb = gin(p, I_RTEB) + l * 32;
    if (F.tid < 32) lcnt[F.tid] = 0;
    __syncthreads();
    const bool act = F.tid < 256 || (crow0 >= 0 && F.tid < 264);
    const int r = F.tid < 256 ? row0 + F.tid : crow0 + (F.tid - 256);
    int e1 = 0, e2 = 0, r1 = 0, r2 = 0; float ga = 0.f, gbb = 0.f;
    if (act) {
        const float* lg = LOG + (size_t)r * 64;
        const bool latr = F.tid < 256; const int fb = (l * 8 + (row0 >> 13)) * 64;
        const float* SNp = (const float*)(F.ws + WS_SNT) + fb; const float* TNp = SNp + 4 * 8 * 64;
        f32x2 st = (f32x2){0.f, 1.f}; if (latr) st = *(const f32x2*)((const float*)(F.ws + WS_ROWST) + 2 * (size_t)r);
        f32x4 g4 = *(const f32x4*)lg;
        if (latr) { const f32x4 sn = *(const f32x4*)SNp, tn = *(const f32x4*)TNp; g4 = (g4 - sn * st.x) * st.y + tn; } else { g4 = g4 + *(const f32x4*)gb; }
        const float g0 = g4[0], g1 = g4[1], g2 = g4[2], g3 = g4[3];
        int gs = 0; float gm = g0; if (g1 > gm) { gm = g1; gs = 1; } if (g2 > gm) { gm = g2; gs = 2; } if (g3 > gm) { gm = g3; gs = 3; }
        const float pg = 1.0f / (__expf(g0 - gm) + __expf(g1 - gm) + __expf(g2 - gm) + __expf(g3 - gm));
        f32x4 ea = *(const f32x4*)(lg + 4 + gs * 8), ec = *(const f32x4*)(lg + 8 + gs * 8);
        if (latr) { ea = (ea - *(const f32x4*)(SNp + 4 + gs * 8) * st.x) * st.y + *(const f32x4*)(TNp + 4 + gs * 8); ec = (ec - *(const f32x4*)(SNp + 8 + gs * 8) * st.x) * st.y + *(const f32x4*)(TNp + 8 + gs * 8); }
        else { ea = ea + *(const f32x4*)(eb + gs * 8); ec = ec + *(const f32x4*)(eb + gs * 8 + 4); }
        float ev[8];
#pragma unroll
        for (int j = 0; j < 4; ++j) { ev[j] = ea[j]; ev[4 + j] = ec[j]; }
        int i1 = 0; float v1 = ev[0];
#pragma unroll
        for (int j = 1; j < 8; ++j) if (ev[j] > v1) { v1 = ev[j]; i1 = j; }
        int i2 = -1; float v2 = -3.0e38f;
#pragma unroll
        for (int j = 0; j < 8; ++j) if (j != i1 && ev[j] > v2) { v2 = ev[j]; i2 = j; }
        const float t = __expf(v2 - v1); ga = pg / (1.0f + t); gbb = pg * t / (1.0f + t);
        e1 = gs * 8 + i1; e2 = gs * 8 + i2;
        r1 = atomicAdd((int*)(lcnt + e1), 1); r2 = atomicAdd((int*)(lcnt + e2), 1);
    }
    __syncthreads();
    if (F.tid < 32) lbase[F.tid] = (int)atomicAdd(gcnt + F.tid, (unsigned)lcnt[F.tid]);
    __syncthreads();
    if (act) { TE[2 * r] = e1; TE[2 * r + 1] = e2; TR[2 * r] = lbase[e1] + r1; TR[2 * r + 1] = lbase[e2] + r2; TG[2 * r] = ga; TG[2 * r + 1] = gbb; }
    __syncthreads();
}
DI void phase_scatter(const Ctx& F, PP p, int l, int ntok) {
    LAS int* pst = (LAS int*)F.lds; LAS int* pcn = pst + 32; LAS int* cn = pst + 64;
    const int* TE = (const int*)(F.ws + WS_TOKE); int* TR = (int*)(F.ws + WS_TOKR); int* ST = (int*)(F.ws + WS_SLOTTOK); int* TILE = (int*)(F.ws + WS_TILEE) + l * 1024;
    unsigned* gcnt = (unsigned*)(F.ws + WS_CTL) + CW_ECNT + l * 64;
    if (F.tid == 0) { int acc = 0; for (int e = 0; e < 32; ++e) { const int cnt = (int)__hip_atomic_load(gcnt + e, __ATOMIC_RELAXED, __HIP_MEMORY_SCOPE_AGENT); const int pc = (cnt + 255) & ~255; pst[e] = acc; pcn[e] = pc; cn[e] = cnt; acc += pc; } pst[96] = acc; }
    __syncthreads();
    for (int idx = F.vcu * 512 + F.tid; idx < 2 * ntok; idx += F.G * 512) { const int e = TE[idx]; const int slot = pst[e] + TR[idx]; ST[slot] = idx >> 1; TR[idx] = slot; }
    for (int e = F.vcu; e < 32; e += F.G) for (int s = pst[e] + cn[e] + F.tid; s < pst[e] + pcn[e]; s += 512) ST[s] = 0;
    if (F.vcu == 0) { for (int t = F.tid; t < 1024; t += 512) { int ee = 0; for (int e = 0; e < 32; ++e) if (t * 256 >= pst[e] && t * 256 < pst[e] + pcn[e]) ee = e; TILE[t] = (t == 1000) ? (pst[96] >> 8) : ee; } }
    __syncthreads();
}

DI void router_ctx_rows(const Ctx& F, int l) {
    const bf16_t* HA = (const bf16_t*)(F.ws + WS_HA); const bf16_t* WR = (const bf16_t*)(F.ws + WS_WR) + (size_t)l * 256 * 1024; float* LOG = (float*)(F.ws + WS_LOG);
    for (int rr = F.vcu * 8 + F.wave; rr < NCTX; rr += F.G * 8) {
        const int r = NLAT + rr; float hv[16];
#pragma unroll
        for (int j = 0; j < 2; ++j) { const u32x4 q = *(const u32x4*)(HA + (size_t)r * D + 8 * F.lane + 512 * j);
#pragma unroll
            for (int i = 0; i < 4; ++i) { hv[8 * j + 2 * i] = bf_lo(q[i]); hv[8 * j + 2 * i + 1] = bf_hi(q[i]); } }
        float mine = 0.f;
        for (int n0 = 0; n0 < 36; n0 += 6) { u32x4 q[6][2];
#pragma unroll
            for (int t = 0; t < 6; ++t)
#pragma unroll
                for (int j = 0; j < 2; ++j) q[t][j] = *(const u32x4*)(WR + (size_t)(n0 + t) * 1024 + 8 * F.lane + 512 * j);
            float a[6];
#pragma unroll
            for (int t = 0; t < 6; ++t) { a[t] = 0.f;
#pragma unroll
                for (int j = 0; j < 2; ++j)
#pragma unroll
                    for (int i = 0; i < 4; ++i) { a[t] += hv[8 * j + 2 * i] * bf_lo(q[t][j][i]); a[t] += hv[8 * j + 2 * i + 1] * bf_hi(q[t][j][i]); } }
#pragma unroll
            for (int t = 0; t < 6; ++t) a[t] = wave_sum(a[t]);
#pragma unroll
            for (int t = 0; t < 6; ++t) mine = (F.lane == n0 + t) ? a[t] : mine; }
        if (F.lane < 36) LOG[(size_t)r * 64 + F.lane] = mine;
    }
}

DI void router_unit(LAS unsigned char* lds, const int tid, const unsigned short* A, const unsigned short* B, float* LOG, const int row0) {
    using namespace pg8;
    constexpr int K = 1024, NT_ = K / BK, STG = 2 * HTB + 8192;
    const int wid = __builtin_amdgcn_readfirstlane(tid >> 6), lane = tid & 63, fr = lane & 15, fq = lane >> 4;
    unsigned voff[2];
#pragma unroll
    for (int i = 0; i < 2; ++i) { int R, C; stage_rc(tid * 16 + i * 8192, R, C); voff[i] = (unsigned)(R * K + C) * 2u; }
    const char* Ag = (const char*)(A + (size_t)row0 * K); const char* Bg = (const char*)B;
    const unsigned ldsw = (unsigned)wid * 1024u;
#define RU_STAGE(st_, kt_) do { const size_t kb_ = (size_t)(kt_) * (BK * 2); LAS unsigned char* sb_ = lds + (st_) * STG + ldsw; \
        __builtin_amdgcn_global_load_lds((const unsigned*)(Ag + kb_ + voff[0]), (LAS unsigned*)(sb_), 16, 0, 2); \
        __builtin_amdgcn_global_load_lds((const unsigned*)(Ag + kb_ + voff[1]), (LAS unsigned*)(sb_ + 8192), 16, 0, 2); \
        __builtin_amdgcn_global_load_lds((const unsigned*)(Ag + (size_t)HALF * K * 2 + kb_ + voff[0]), (LAS unsigned*)(sb_ + HTB), 16, 0, 2); \
        __builtin_amdgcn_global_load_lds((const unsigned*)(Ag + (size_t)HALF * K * 2 + kb_ + voff[1]), (LAS unsigned*)(sb_ + HTB + 8192), 16, 0, 2); \
        __builtin_amdgcn_global_load_lds((const unsigned*)(Bg + kb_ + voff[0]), (LAS unsigned*)(sb_ + 2 * HTB), 16, 0, 0); } while (0)
    const int aoff = (wid >> 2) * HTB + lds_byte(32 * (wid & 3) + fr, fq * 8), boff = 2 * HTB + lds_byte(fr, fq * 8);
    f32x4 acc[2][3];
#pragma unroll
    for (int m = 0; m < 2; ++m)
#pragma unroll
        for (int j = 0; j < 3; ++j) acc[m][j] = (f32x4){0.f, 0.f, 0.f, 0.f};
    asm volatile("" ::: "memory");
    RU_STAGE(0, 0); RU_STAGE(1, 1);
    int sc = 0, sn = 2;
#pragma unroll 1
    for (int t = 0; t < NT_; ++t) {
        if (t + 1 < NT_) asm volatile("s_waitcnt vmcnt(5)" ::: "memory"); else asm volatile("s_waitcnt vmcnt(0)" ::: "memory");
        asm volatile("s_waitcnt lgkmcnt(0)" ::: "memory");
        __builtin_amdgcn_s_barrier();
        asm volatile("" ::: "memory");
        if (t + 2 < NT_) RU_STAGE(sn, t + 2);
        const LAS unsigned char* sb = lds + sc * STG;
        f16x8 Af[2][2], Bf[3][2];
#pragma unroll
        for (int m = 0; m < 2; ++m)
#pragma unroll
            for (int k = 0; k < 2; ++k) Af[m][k] = *(const LAS f16x8*)(sb + aoff + m * 2048 + k * 1024);
#pragma unroll
        for (int j = 0; j < 3; ++j)
#pragma unroll
            for (int k = 0; k < 2; ++k) Bf[j][k] = *(const LAS f16x8*)(sb + boff + j * 2048 + k * 1024);
#pragma unroll
        for (int m = 0; m < 2; ++m)
#pragma unroll
            for (int j = 0; j < 3; ++j)
#pragma unroll
                for (int k = 0; k < 2; ++k) acc[m][j] = __builtin_amdgcn_mfma_f32_16x16x32_f16(Bf[j][k], Af[m][k], acc[m][j], 0, 0, 0);
        sc = (sc == 2) ? 0 : sc + 1; sn = (sn == 2) ? 0 : sn + 1;
    }
#undef RU_STAGE
#pragma unroll
    for (int m = 0; m < 2; ++m)
#pragma unroll
        for (int j = 0; j < 3; ++j) *(f32x4*)(LOG + (size_t)(row0 + 32 * wid + 16 * m + fr) * 64 + 16 * j + 4 * fq) = acc[m][j];
    __syncthreads();
}

constexpr int NPHASE = 2 + 9 * DEPTH;
#ifndef MK_MULTI_LAUNCH
#define MK_MULTI_LAUNCH 0
#endif

__global__ void __launch_bounds__(512, 2) mega_fwd(Params p) {
    extern __shared__ __attribute__((aligned(16))) unsigned char lds_raw[];
    LAS unsigned char* const lds0 = (LAS unsigned char*)lds_raw;
    const int wave0 = __builtin_amdgcn_readfirstlane((int)threadIdx.x >> 6);
#define LEADER() (wave0 == 0 && lane_id_v() == 0)
#define MKCTX() Ctx F; { int t_ = wave0 * 64 + lane_id_v(); F.tid = t_; F.lane = t_ & 63; F.wave = __builtin_amdgcn_readfirstlane(t_ >> 6); \
        int g_ = gridDim.x, bx_ = blockIdx.x; asm volatile("" : "+s"(g_), "+s"(bx_)); F.G = g_; F.bx = bx_; F.vcu = (g_ % 8 == 0) ? (bx_ % 8) * (g_ / 8) + bx_ / 8 : bx_; \
        GAS unsigned char* w_ = (GAS unsigned char*)p.ws; GAS float* o_ = (GAS float*)p.out; asm volatile("" : "+s"(w_), "+s"(o_)); F.ws = (unsigned char*)w_; F.out = (float*)o_; F.lds = lds0; } \
        PP pk = (PP)__builtin_amdgcn_kernarg_segment_ptr(); asm volatile("" : "+s"(pk));
    volatile LAS unsigned* MISC = (volatile LAS unsigned*)(lds0 + MISC_OFF);
    if (wave0 == 0) MISC[lane_id_v()] = 0u;
    __syncthreads();
    unsigned* ctl = (unsigned*)(p.ws + WS_CTL);
    XcdBarrier bar; bar.bar = ctl + CW_BAR; bar.x = 0; bar.st = MISC + 8;
    if (p.ph_hi - p.ph_lo > 1) bar = xcd_barrier_post(ctl + CW_BAR, MISC + 8, LEADER());
#ifndef EN_MASK
#define EN_MASK 0xFFFF
#endif
#define EN(b) ((EN_MASK >> (b)) & 1)
#ifndef REP_MASK
#define REP_MASK 0
#endif
#define REPN(b) (((REP_MASK >> (b)) & 1) ? 2 : 1)
#define RUN(k) (p.ph_lo <= (k) && (k) < p.ph_hi)
#define SEAM(k) do { if (RUN(k) && RUN((k) + 1)) xcd_barrier(bar, LEADER()); } while (0)

    if (RUN(0) && EN(11)) for (int rep = 0; rep < REPN(11); ++rep) { MKCTX(); phase_prologue_a(F, pk); } SEAM(0);
    if (RUN(1) && EN(12)) for (int rep = 0; rep < REPN(12); ++rep) { { MKCTX(); router_fold_weights(F, pk); } MKCTX(); phase_rows<0, true>(F, pk, 0, NT); } SEAM(1);

    for (int l = 0; l < DEPTH; ++l) {
        const int pb = 2 + 9 * l;
        const bool lastl = (l == DEPTH - 1);
        const int nrows = lastl ? NLAT : NT;
        if (RUN(pb + 0) && EN(0)) for (int rep = 0; rep < REPN(0); ++rep) { MKCTX();
            pg8::StaticOrder S; S.init(NLAT, DIN, 1024, F.G, F.bx); S.wgm = 4;
            { LAS float* rl = (LAS float*)(F.lds + ROPE_OFF); const float* rg = (const float*)(F.ws + WS_ROPE); for (int i = F.tid; i < 128 * 32; i += 512) rl[i] = rg[i]; }
            __syncthreads();
            pg8::EpiInproj E{(bf16_t*)(F.ws + WS_U), (bf16_t*)(F.ws + WS_G), (bf16_t*)(F.ws + WS_Q), (bf16_t*)(F.ws + WS_KB), (bf16_t*)(F.ws + WS_VT), (bf16_t*)(F.ws + WS_VTC), (const LAS float*)(F.lds + ROPE_OFF)};
            pg8::gemm_phase<pg8::EpiInproj, pg8::StaticOrder>(F.lds, F.tid, (const bf16_t*)(F.ws + WS_HA), (const bf16_t*)(F.ws + WS_WIN) + (size_t)l * DIN * 1024, 1024, S, E);
        } SEAM(pb + 0);
        if (RUN(pb + 1) && EN(1)) for (int rep = 0; rep < REPN(1); ++rep) { MKCTX(); phase_scan(F, pk, l); } SEAM(pb + 1);
        if (RUN(pb + 2) && EN(2)) for (int rep = 0; rep < REPN(2); ++rep) { MKCTX(); phase_attn(F, pk, l); } SEAM(pb + 2);
        if (RUN(pb + 3) && EN(3)) for (int rep = 0; rep < REPN(3); ++rep) { MKCTX();
            pg8::StaticOrder S; S.init(NLAT, 1024, 1024, F.G, F.bx);
            pg8::EpiPlainBf16 E{(bf16_t*)(F.ws + WS_Y), D, 1.0f};
            pg8::gemm_phase<pg8::EpiPlainBf16, pg8::StaticOrder>(F.lds, F.tid, (const bf16_t*)(F.ws + WS_HA), (const bf16_t*)(F.ws + WS_WOUT) + (size_t)l * 1024 * 1024, 1024, S, E);
        } SEAM(pb + 3);
        if (RUN(pb + 4) && EN(4)) for (int rep = 0; rep < REPN(4); ++rep) { MKCTX(); phase_rows<1, false>(F, pk, l, nrows);
            asm volatile("s_waitcnt vmcnt(0)" ::: "memory"); __syncthreads();
            router_unit(F.lds, F.tid, (const unsigned short*)(F.ws + WS_XB), (const unsigned short*)(F.ws + WS_WRB) + (size_t)(l * 8 + (F.vcu >> 5)) * 64 * 1024, (float*)(F.ws + WS_LOG), 256 * F.vcu);
            if (!lastl) router_ctx_rows(F, l);
            asm volatile("s_waitcnt vmcnt(0)" ::: "memory"); __syncthreads();
            route_block(F, pk, l, 256 * F.vcu, lastl ? -1 : NLAT + 8 * F.vcu);
        } SEAM(pb + 4);
        if (RUN(pb + 5) && EN(7)) for (int rep = 0; rep < REPN(7); ++rep) { MKCTX(); phase_scatter(F, pk, l, nrows); if (l >= 1) bg_moe_weights(F, pk, l, -1);   } SEAM(pb + 5);
        if (RUN(pb + 6) && EN(8)) for (int rep = 0; rep < REPN(8); ++rep) { MKCTX();
            const int* TILE = (const int*)(F.ws + WS_TILEE) + l * 1024; const int ntiles = __builtin_amdgcn_readfirstlane(TILE[1000]);
            LAS int* toktab = (LAS int*)(F.lds + TOKTAB_OFF);
            pg8::MoeOrder<true> S; S.ntiles = ntiles; S.nN = 4; S.G = F.G; S.c = F.vcu; S.K = 512; S.tile_e = TILE; S.estride = (size_t)1024 * 1024; S.toktab = toktab;
            { const int* ST = (const int*)(F.ws + WS_SLOTTOK); pg8::Unit u; for (int i = 0; i < 12 && S.next(i, u); ++i) if (F.tid < 256) toktab[i * 256 + F.tid] = ST[u.pm * 256 + F.tid]; }
            __syncthreads();
            pg8::EpiSwigluF8 E{(unsigned char*)(F.ws + WS_HMOE)};
            pg8::gemm_phase<pg8::EpiSwigluF8, pg8::MoeOrder<true>, true>(F.lds, F.tid, (const bf16_t*)(F.ws + WS_HA8), (const bf16_t*)(F.ws + WS_W13 + (size_t)l * NE * 1024 * 1024), 512, S, E);
            if ((ntiles * 4) % F.G != 0 && F.vcu >= (ntiles * 4) % F.G) bg_moe_weights(F, pk, l + 1, 4);
        } SEAM(pb + 6);
        if (RUN(pb + 7) && EN(9)) for (int rep = 0; rep < REPN(9); ++rep) { MKCTX();
            const int* TILE = (const int*)(F.ws + WS_TILEE) + l * 1024; const int ntiles = __builtin_amdgcn_readfirstlane(TILE[1000]);
            pg8::MoeOrder<false> S; S.ntiles = ntiles; S.nN = 4; S.G = F.G; S.c = F.vcu; S.K = 256; S.tile_e = TILE; S.estride = (size_t)1024 * DE; S.toktab = nullptr;
            pg8::EpiPlainF8 E{(unsigned char*)(F.ws + WS_YMOE), D, pg8::F8_SY / (pg8::F8_SH * pg8::F8_SW2)};
            pg8::gemm_phase<pg8::EpiPlainF8, pg8::MoeOrder<false>, true>(F.lds, F.tid, (const bf16_t*)(F.ws + WS_HMOE), (const bf16_t*)(F.ws + WS_W2 + (size_t)l * NE * 1024 * DE), 256, S, E);
            if ((ntiles * 4) % F.G != 0 && F.vcu >= (ntiles * 4) % F.G) bg_moe_weights(F, pk, l + 1, 3);
        } SEAM(pb + 7);
        if (RUN(pb + 8) && EN(10)) for (int rep = 0; rep < REPN(10); ++rep) { MKCTX(); if (lastl) phase_rows<2, false>(F, pk, l, nrows); else phase_rows<2, true>(F, pk, l, nrows); } SEAM(pb + 8);
    }
#undef RUN
#undef SEAM
}

extern "C" void kernel_launch(void* const* d_in, const int* in_sizes, int n_in, void* d_out, int out_size, void* d_ws, size_t ws_size, hipStream_t stream) {
    static int grid = 0;
    if (grid == 0) {
        if (n_in != 29 || out_size != NLAT * D || ws_size < WS_END) { fprintf(stderr, "kernel_launch: unexpected shapes (n_in %d out %d ws %zu, need %zu)\n", n_in, out_size, ws_size, (size_t)WS_END); grid = -1; return; }
        int dev = 0, cus = 0, per_cu = 0;
        if (hipGetDevice(&dev) != hipSuccess || hipDeviceGetAttribute(&cus, hipDeviceAttributeMultiprocessorCount, dev) != hipSuccess) { grid = -1; return; }
        if (hipFuncSetAttribute((const void*)mega_fwd, hipFuncAttributeMaxDynamicSharedMemorySize, LDS_BYTES) != hipSuccess) { fprintf(stderr, "kernel_launch: hipFuncSetAttribute failed\n"); grid = -1; return; }
        if (hipOccupancyMaxActiveBlocksPerMultiprocessor(&per_cu, (const void*)mega_fwd, 512, LDS_BYTES) != hipSuccess || per_cu < 1) fprintf(stderr, "kernel_launch: occupancy query says %d\n", per_cu);
        (void)hipGetLastError();
        grid = cus;
    }
    if (grid < 0) return;
    (void)hipMemsetAsync((char*)d_ws + WS_CTL, 0, CTL_ZERO_BYTES, stream);
    Params p{};
    for (int i = 0; i < 29; ++i) p.in[i] = (const float*)d_in[i];
    p.out = (float*)d_out; p.ws = (unsigned char*)d_ws;
#if MK_MULTI_LAUNCH
    for (int k = 0; k < NPHASE; ++k) { p.ph_lo = k; p.ph_hi = k + 1; hipLaunchKernelGGL(mega_fwd, dim3(grid), dim3(512), LDS_BYTES, stream, p); }
#else
    p.ph_lo = 0; p.ph_hi = NPHASE;
    hipLaunchKernelGGL(mega_fwd, dim3(grid), dim3(512), LDS_BYTES, stream, p);
#endif
    const hipError_t le = hipPeekAtLastError();
    if (le != hipSuccess) fprintf(stderr, "kernel_launch: launch failed: %s\n", hipGetErrorName(le));
}
```
